# Optimizing an MI355X kernel written in HIP

```python
import math
import jax, jax.numpy as jnp
from jax import lax
import numpy as np

D_MODEL = 2048
BATCH = 4
SEQ = 4096
DEPTH = 1

HEAD_DIM_A = D_MODEL // 16
ATTN_GROUPS = ((128, 1), (512, 4), (2048, 16))
N_GROUPS = len(ATTN_GROUPS)
HEADS_PER_GROUP = 4
N_HEADS_A = N_GROUPS * HEADS_PER_GROUP
WIDTH_A = N_HEADS_A * HEAD_DIM_A
OUT_WIDTH_A = HEADS_PER_GROUP * HEAD_DIM_A
BLK = 64
N_BUCKETS = 32
MAX_DISTANCE = 1024
LRU_WIDTH = 3 * D_MODEL // 4
LRU_BLOCKS = 12
LRU_BW = LRU_WIDTH // LRU_BLOCKS
CONV_WIDTH = 4
LRU_C = 8.0
N_MEM = 256
MEM_HEADS = 4
MEM_HEAD_DIM = D_MODEL // 8
MEM_WIDTH = MEM_HEADS * MEM_HEAD_DIM
D_FF = 4 * D_MODEL
N_BRANCH = 3
EPS = 1e-6

N_IN = 3 * WIDTH_A + 2 * LRU_WIDTH + MEM_WIDTH
IN_SPLITS = (WIDTH_A, 2 * WIDTH_A, 3 * WIDTH_A, 3 * WIDTH_A + LRU_WIDTH, 3 * WIDTH_A + 2 * LRU_WIDTH)

kernel_name = "hybrid_dilated_rglru_memxattn_block"


def rms_norm(t, gain):
    tf = t.astype(jnp.float32)
    y = tf * lax.rsqrt(jnp.mean(tf * tf, axis=-1, keepdims=True) + EPS) * gain.astype(jnp.float32)
    return y.astype(t.dtype)


def t5_bucket(rel):
    nb = N_BUCKETS // 2
    max_exact = nb // 2
    sign = (rel > 0).astype(np.int32) * nb
    n = np.abs(rel)
    large = max_exact + (np.log(np.maximum(n, 1) / max_exact)
                         / np.log(MAX_DISTANCE / max_exact) * (nb - max_exact)).astype(np.int32)
    large = np.minimum(large, nb - 1)
    return (sign + np.where(n < max_exact, n, large)).astype(np.int32)


def dilated_window_attention(q, k, v, bias_table, window, dilation):
    B, S, H, C = q.shape
    d = dilation
    L = S // d
    radius = window // (2 * d)
    nblk = -(-L // BLK)
    Lp = nblk * BLK
    pad = Lp - L

    def to_strided(t):
        return t.reshape(B, L, d, H, C).transpose(0, 2, 1, 3, 4)

    qs, ks, vs = to_strided(q), to_strided(k), to_strided(v)
    qb = jnp.pad(qs, ((0, 0), (0, 0), (0, pad), (0, 0), (0, 0))).reshape(B, d, nblk, BLK, H, C)

    def windows(t):
        tp = jnp.pad(t, ((0, 0), (0, 0), (BLK, pad + BLK), (0, 0), (0, 0)))
        tb = tp.reshape(B, d, nblk + 2, BLK, H, C)
        return jnp.concatenate([tb[:, :, :-2], tb[:, :, 1:-1], tb[:, :, 2:]], axis=3)

    kw, vw = windows(ks), windows(vs)

    qq = np.arange(BLK)[:, None]
    kk = np.arange(3 * BLK)[None, :]
    rel = kk - BLK - qq
    band = np.abs(rel) <= radius
    key_pos = (np.arange(nblk)[:, None, None] - 1) * BLK + kk[None]
    valid = band[None] & (key_pos >= 0) & (key_pos < L)
    bias = bias_table.astype(jnp.float32)[t5_bucket(rel * d)]
    bias = jnp.transpose(bias, (2, 0, 1))

    scale = 1.0 / math.sqrt(C)
    logits = jnp.einsum('brnqhc,brnkhc->brnhqk', qb, kw).astype(jnp.float32) * scale
    logits = logits + bias[None, None, None]
    logits = jnp.where(valid[None, None, :, None], logits, -1e30)
    m = jnp.max(logits, axis=-1, keepdims=True)
    p = jnp.exp(logits - m)
    s = jnp.sum(p, axis=-1, keepdims=True)
    o = jnp.einsum('brnhqk,brnkhc->brnqhc', p.astype(vw.dtype), vw).astype(jnp.float32)
    o = o / jnp.swapaxes(s, 3, 4)
    lse = jnp.swapaxes((m + jnp.log(s))[..., 0], 3, 4)

    o = o.reshape(B, d, Lp, H, C)[:, :, :L].transpose(0, 2, 1, 3, 4).reshape(B, S, H, C)
    lse = lse.reshape(B, d, Lp, H)[:, :, :L].transpose(0, 2, 1, 3).reshape(B, S, H)
    return o, lse


def _lin_combine(left, right):
    a1, b1 = left
    a2, b2 = right
    return a1 * a2, a2 * b1 + b2


def rg_lru_forward(xc, wa, ba, wi, bi, lam):
    B, S, W = xc.shape
    xb = xc.reshape(B, S, LRU_BLOCKS, LRU_BW)
    r = jax.nn.sigmoid(jnp.einsum('bsnc,ncd->bsnd', xb, wa.astype(jnp.float32)) + ba.astype(jnp.float32)).reshape(B, S, W)
    i = jax.nn.sigmoid(jnp.einsum('bsnc,ncd->bsnd', xb, wi.astype(jnp.float32)) + bi.astype(jnp.float32)).reshape(B, S, W)
    log_a = -LRU_C * jax.nn.softplus(-lam.astype(jnp.float32)) * r
    a = jnp.exp(log_a)
    is_start = (jnp.arange(S) == 0)[None, :, None]
    mult = jnp.where(is_start, 1.0, jnp.sqrt(-jnp.expm1(2.0 * log_a)))
    b = mult * (i * xc)
    _, h = lax.associative_scan(_lin_combine, (a, b), axis=1)
    return h


def setup_inputs(seed: int = 0) -> dict:
    key = jax.random.key(seed)
    ks = jax.random.split(key, 32)
    f32 = jnp.float32

    def dense(k, shape, fan_in):
        return jax.random.normal(k, shape, f32) * (fan_in ** -0.5)

    def gain(k, shape):
        return 1.0 + 0.02 * jax.random.normal(k, shape, f32)

    def small(k, shape):
        return 0.01 * jax.random.normal(k, shape, f32)

    u = jax.random.uniform(ks[14], (DEPTH, 2, LRU_WIDTH), f32, 0.9, 0.999)
    a_base = u ** (1.0 / LRU_C)
    lru_lambda = jnp.log(a_base) - jnp.log1p(-a_base)

    return {
        "x": jax.random.normal(ks[0], (BATCH, SEQ, D_MODEL), f32),
        "mem": jax.random.normal(ks[1], (BATCH, N_MEM, D_MODEL), f32),
        "rel_bias": 0.1 * jax.random.normal(ks[2], (N_BUCKETS, N_HEADS_A), f32),
        "norm_mix": gain(ks[3], (DEPTH, D_MODEL)),
        "norm_mem": gain(ks[4], (DEPTH, D_MODEL)),
        "norm_mlp": gain(ks[5], (DEPTH, D_MODEL)),
        "norm_final": gain(ks[6], (D_MODEL,)),
        "w_in": dense(ks[7], (DEPTH, D_MODEL, N_IN), D_MODEL),
        "w_gate": dense(ks[8], (DEPTH, D_MODEL, N_BRANCH * D_MODEL), D_MODEL),
        "b_gate": small(ks[9], (DEPTH, N_BRANCH * D_MODEL)),
        "conv_w": dense(ks[10], (DEPTH, CONV_WIDTH, LRU_WIDTH), CONV_WIDTH),
        "conv_b": small(ks[11], (DEPTH, LRU_WIDTH)),
        "lru_wa": dense(ks[12], (DEPTH, 2, LRU_BLOCKS, LRU_BW, LRU_BW), LRU_BW),
        "lru_ba": small(ks[13], (DEPTH, 2, LRU_BLOCKS, LRU_BW)),
        "lru_wi": dense(ks[15], (DEPTH, 2, LRU_BLOCKS, LRU_BW, LRU_BW), LRU_BW),
        "lru_bi": small(ks[16], (DEPTH, 2, LRU_BLOCKS, LRU_BW)),
        "lru_lambda": lru_lambda,
        "w_mem_kv": dense(ks[17], (DEPTH, D_MODEL, 2 * MEM_WIDTH), D_MODEL),
        "w_o_attn": dense(ks[18], (DEPTH, OUT_WIDTH_A, D_MODEL), OUT_WIDTH_A),
        "w_o_lru": dense(ks[19], (DEPTH, LRU_WIDTH, D_MODEL), LRU_WIDTH),
        "w_o_mem": dense(ks[20], (DEPTH, MEM_WIDTH, D_MODEL), MEM_WIDTH),
        "w_out": dense(ks[21], (DEPTH, D_MODEL, D_MODEL), D_MODEL),
        "w_up": dense(ks[22], (DEPTH, D_MODEL, D_FF), D_MODEL),
        "w_down": dense(ks[23], (DEPTH, D_FF, D_MODEL), D_FF),
    }


def reference(x, mem, rel_bias, norm_mix, norm_mem, norm_mlp, norm_final, w_in, w_gate, b_gate,
              conv_w, conv_b, lru_wa, lru_ba, lru_wi, lru_bi, lru_lambda, w_mem_kv,
              w_o_attn, w_o_lru, w_o_mem, w_out, w_up, w_down):
    B, S, _ = x.shape
    for l in range(DEPTH):
        h = rms_norm(x, norm_mix[l])
        proj = h @ w_in[l]
        q_a, k_a, v_a, x_b, y_b, q_c = jnp.split(proj, IN_SPLITS, axis=-1)

        q_a = q_a.reshape(B, S, N_HEADS_A, HEAD_DIM_A)
        k_a = k_a.reshape(B, S, N_HEADS_A, HEAD_DIM_A)
        v_a = v_a.reshape(B, S, N_HEADS_A, HEAD_DIM_A)
        outs, lses = [], []
        for g, (window, dil) in enumerate(ATTN_GROUPS):
            hs = slice(g * HEADS_PER_GROUP, (g + 1) * HEADS_PER_GROUP)
            o, lse = dilated_window_attention(q_a[:, :, hs], k_a[:, :, hs], v_a[:, :, hs],
                                              rel_bias[:, hs], window, dil)
            outs.append(o)
            lses.append(lse)
        wts = jax.nn.softmax(jnp.stack(lses), axis=0)
        y_a = jnp.einsum('gbsh,gbshc->bshc', wts, jnp.stack(outs))
        y_a = y_a.reshape(B, S, OUT_WIDTH_A).astype(h.dtype) @ w_o_attn[l]

        kern = conv_w[l].reshape(CONV_WIDTH, 1, LRU_WIDTH).astype(x_b.dtype)
        xc = lax.conv_general_dilated(x_b, kern, window_strides=(1,), padding=[(1, 2)],
                                      dimension_numbers=('NWC', 'WIO', 'NWC'),
                                      feature_group_count=LRU_WIDTH) + conv_b[l]
        xc = xc.astype(jnp.float32)
        h_fwd = rg_lru_forward(xc, lru_wa[l, 0], lru_ba[l, 0], lru_wi[l, 0], lru_bi[l, 0], lru_lambda[l, 0])
        h_bwd = jnp.flip(rg_lru_forward(jnp.flip(xc, axis=1), lru_wa[l, 1], lru_ba[l, 1],
                                        lru_wi[l, 1], lru_bi[l, 1], lru_lambda[l, 1]), axis=1)
        y_lru = (h_fwd + h_bwd).astype(h.dtype) * jax.nn.gelu(y_b)
        y_lru = y_lru @ w_o_lru[l]

        mem_n = rms_norm(mem, norm_mem[l])
        k_c, v_c = jnp.split(mem_n @ w_mem_kv[l], 2, axis=-1)
        q_c = q_c.reshape(B, S, MEM_HEADS, MEM_HEAD_DIM)
        k_c = k_c.reshape(B, N_MEM, MEM_HEADS, MEM_HEAD_DIM)
        v_c = v_c.reshape(B, N_MEM, MEM_HEADS, MEM_HEAD_DIM)
        logits_c = jnp.einsum('bshc,bmhc->bhsm', q_c, k_c).astype(jnp.float32) * (1.0 / math.sqrt(MEM_HEAD_DIM))
        p_c = jax.nn.softmax(logits_c, axis=-1)
        y_c = jnp.einsum('bhsm,bmhc->bshc', p_c.astype(v_c.dtype), v_c).reshape(B, S, MEM_WIDTH)
        y_c = y_c @ w_o_mem[l]

        gates = jax.nn.sigmoid((h @ w_gate[l] + b_gate[l]).astype(jnp.float32)).astype(h.dtype)
        g_a, g_b, g_c = jnp.split(gates, N_BRANCH, axis=-1)
        mixed = g_a * y_a + g_b * y_lru + g_c * y_c
        x = x + mixed @ w_out[l]

        h2 = rms_norm(x, norm_mlp[l])
        x = x + jnp.square(jax.nn.relu(h2 @ w_up[l])) @ w_down[l]

    return rms_norm(x, norm_final)
```

```cpp
#include <hip/hip_runtime.h>
#include <hip/hip_cooperative_groups.h>
#include <cstdio>
#include <cstdint>
#include <type_traits>
namespace cg = cooperative_groups;

#define LAS __attribute__((address_space(3)))
typedef unsigned short bf16_t;
typedef short bf16x8 __attribute__((ext_vector_type(8)));
typedef short s16x4 __attribute__((ext_vector_type(4)));
typedef float f32x4 __attribute__((ext_vector_type(4)));
typedef float f32x2 __attribute__((ext_vector_type(2)));
typedef unsigned u32x4 __attribute__((ext_vector_type(4)));
typedef unsigned u32x2 __attribute__((ext_vector_type(2)));

constexpr int D = 2048, BATCH = 4, SEQ = 4096, M = BATCH * SEQ;
constexpr int NIN = 8704, NG = 6144, DFF = 8192, NMEM = 256;
constexpr int C_Q = 0, C_K = 1536, C_V = 3072, C_XB = 4608, C_YB = 6144, C_QC = 7680;
constexpr int YP = 3072;
constexpr float EPS = 1e-6f;
constexpr int NCHUNK = 16, CHUNK = 256;

constexpr size_t MiB = 1u << 20;
constexpr size_t WS_TAB = 0;
constexpr size_t WS_BAR = 65536;
constexpr size_t WS_LSE = 1 * MiB;
constexpr size_t WS_AGG = 2 * MiB;
constexpr size_t WS_SSQ = 3 * MiB + 768 * 1024;
constexpr size_t WS_H2 = 14 * MiB;
constexpr size_t WS_WLRU = 4 * MiB;
constexpr size_t WS_MEMN = 6 * MiB;
constexpr size_t WS_KV = 10 * MiB;
constexpr size_t WS_WIN = 14 * MiB;
constexpr size_t WS_WGATE = 48 * MiB;
constexpr size_t WS_WMKV = 72 * MiB;
constexpr size_t WS_WO = 80 * MiB;
constexpr size_t WS_WOUT = 92 * MiB;
constexpr size_t WS_WUP = 100 * MiB;
constexpr size_t WS_WDN = 132 * MiB;
constexpr size_t WS_H = 164 * MiB;
constexpr size_t WS_PROJ = 228 * MiB;
constexpr size_t WS_END = 500 * MiB;
constexpr size_t DO_O12 = 96 * MiB;

constexpr int LDS_BYTES = 147456;
constexpr int LDS_XB = 147456 - 64;

__device__ __forceinline__ unsigned cvt_pk_bf16(float lo, float hi) { unsigned r; asm volatile("v_cvt_pk_bf16_f32 %0, %1, %2" : "=v"(r) : "v"(lo), "v"(hi)); return r; }
__device__ __forceinline__ float bf2f(unsigned short b) { return __uint_as_float(((unsigned)b) << 16); }
__device__ __forceinline__ float bflo(unsigned w) { return __uint_as_float(w << 16); }
__device__ __forceinline__ float bfhi(unsigned w) { return __uint_as_float(w & 0xffff0000u); }
__device__ __forceinline__ float wave_sum(float v) {
#pragma unroll
    for (int o = 1; o < 64; o <<= 1) v += __shfl_xor(v, o);
    return v;
}
__device__ __forceinline__ float sigmoidf_(float x) { return 1.0f / (1.0f + __expf(-x)); }
__device__ __forceinline__ float gelu_tanh(float x) { const float u = 0.7978845608028654f * (x + 0.044715f * x * x * x); return 0.5f * x * (1.0f + tanhf(u)); }

namespace pg8 {
constexpr int BM = 256, BK = 64, HALF = 128, HTB = HALF * BK * 2, STAGE_BYTES = 8 * HTB, NXCD = 8, WGM = 8;
__host__ __device__ __forceinline__ int lds_byte(int r, int c) { const int st = (r >> 4) * 2 + (c >> 5), rr = r & 15, cc = c & 31, ob = rr * 64 + cc * 2; return st * 1024 + (ob ^ (((ob >> 9) & 1) << 5)); }
__host__ __device__ __forceinline__ void stage_rc(int b, int& R, int& C) { const int st = b / 1024, sb = b % 1024, swz = sb ^ (((sb >> 9) & 1) << 5); R = (st >> 1) * 16 + swz / 64; C = (st & 1) * 32 + (swz % 64) / 2; }
__host__ __device__ __forceinline__ int perm32(int rho) { const int n = rho >> 4, i = rho & 15; return 8 * (i >> 2) + 4 * n + (i & 3); }

struct Unit { int pm, pn; };
struct Gemm { const bf16_t* A; const bf16_t* Bt; int M, N, K, lda, ldb; };

struct StaticOrder {
    int nM, nN, nwg, G, c, rep, wgm;
    __host__ __device__ void init(int M_, int N_, int G_, int c_, int rep_ = 1, int wgm_ = WGM) { nM = M_ / BM; nN = N_ / BM; nwg = nM * nN; G = G_; c = c_; rep = rep_; wgm = wgm_; }
    __host__ __device__ bool next(int i, Unit& u) const {
        long L = (long)i * G + c; if (c < 0 || L >= (long)nwg * rep) return false;
        if (L >= nwg) L -= nwg;
        int wgid = (int)L; { const int q = nwg / NXCD, r = nwg % NXCD, xcd = wgid % NXCD, off = wgid / NXCD; wgid = (xcd < r ? xcd * (q + 1) : r * (q + 1) + (xcd - r) * q) + off; }
        const int nig = wgm * nN, gid = wgid / nig, fm = gid * wgm, gsz = (nM - fm) < wgm ? (nM - fm) : wgm;
        u.pm = fm + ((wgid % nig) % gsz); u.pn = (wgid % nig) / gsz; return true;
    }
};

template <int ACT  > struct EpiBf16 {
    static constexpr bool PERM = true, MID = false;
    bf16_t* O; int ldc; const float* bias;
    __device__ __forceinline__ void operator()(const f32x4 (&acc)[2][2][4][2], const Unit& u, int wr, int wc, int fr, int fq) const {
        const int row0 = u.pm * BM + wr * 64 + fr; const int col0 = u.pn * BM + wc * 32 + 8 * fq;
        f32x4 bv[2][2];
#pragma unroll
        for (int bj = 0; bj < 2; ++bj)
#pragma unroll
            for (int n = 0; n < 2; ++n) bv[bj][n] = (ACT == 1) ? *(const f32x4*)(bias + col0 + bj * HALF + 4 * n) : (f32x4){0.f, 0.f, 0.f, 0.f};
#pragma unroll
        for (int ai = 0; ai < 2; ++ai)
#pragma unroll
            for (int m = 0; m < 4; ++m) { bf16_t* rowp = O + (size_t)(row0 + ai * HALF + m * 16) * ldc + col0;
#pragma unroll
                for (int bj = 0; bj < 2; ++bj) { f32x4 v0 = acc[ai][bj][m][0], v1 = acc[ai][bj][m][1];
                    if (ACT == 1) { v0 += bv[bj][0]; v1 += bv[bj][1];
#pragma unroll
                        for (int j = 0; j < 4; ++j) { v0[j] = sigmoidf_(v0[j]); v1[j] = sigmoidf_(v1[j]); } }
                    if (ACT == 2) {
#pragma unroll
                        for (int j = 0; j < 4; ++j) { const float a = fmaxf(v0[j], 0.f), b = fmaxf(v1[j], 0.f); v0[j] = a * a; v1[j] = b * b; } }
                    u32x4 w; w.x = cvt_pk_bf16(v0[0], v0[1]); w.y = cvt_pk_bf16(v0[2], v0[3]); w.z = cvt_pk_bf16(v1[0], v1[1]); w.w = cvt_pk_bf16(v1[2], v1[3]);
                    *(u32x4*)(rowp + bj * HALF) = w; } }
    }
};
struct EpiResF32 {
    static constexpr bool PERM = false, MID = false;
    float* out; const float* res; int ldc;
    __device__ __forceinline__ void operator()(const f32x4 (&acc)[2][2][4][2], const Unit& u, int wr, int wc, int fr, int fq) const {
        const int row0 = u.pm * BM + wr * 64 + fr, col0 = u.pn * BM + wc * 32 + 4 * fq;
#pragma unroll
        for (int ai = 0; ai < 2; ++ai)
#pragma unroll
            for (int m = 0; m < 4; ++m) { const size_t off = (size_t)(row0 + ai * HALF + m * 16) * ldc + col0;
#pragma unroll
                for (int bj = 0; bj < 2; ++bj)
#pragma unroll
                    for (int n = 0; n < 2; ++n) { const f32x4 r = *(const f32x4*)(res + off + bj * HALF + n * 16); *(f32x4*)(out + off + bj * HALF + n * 16) = acc[ai][bj][m][n] + r; } }
    }
};
struct EpiResNorm {
    static constexpr bool PERM = false, MID = false;
    float* out; const float* res; const float* gain; bf16_t* xg; float* ssq;
    __device__ __forceinline__ void operator()(const f32x4 (&acc)[2][2][4][2], const Unit& u, int wr, int wc, int fr, int fq) const {
        const int row0 = u.pm * BM + wr * 64 + fr, col0 = u.pn * BM + wc * 32 + 4 * fq;
        f32x4 gv[2][2];
#pragma unroll
        for (int bj = 0; bj < 2; ++bj)
#pragma unroll
            for (int n = 0; n < 2; ++n) gv[bj][n] = *(const f32x4*)(gain + col0 + bj * HALF + n * 16);
#pragma unroll
        for (int ai = 0; ai < 2; ++ai)
#pragma unroll
            for (int m = 0; m < 4; ++m) { const int row = row0 + ai * HALF + m * 16; const size_t off = (size_t)row * D + col0; float sq = 0.f;
#pragma unroll
                for (int bj = 0; bj < 2; ++bj)
#pragma unroll
                    for (int n = 0; n < 2; ++n) { const f32x4 r = *(const f32x4*)(res + off + bj * HALF + n * 16); const f32x4 v = acc[ai][bj][m][n] + r;
                        *(f32x4*)(out + off + bj * HALF + n * 16) = v; sq += (v[0] * v[0] + v[1] * v[1]) + (v[2] * v[2] + v[3] * v[3]);
                        const f32x4 g = gv[bj][n]; u32x2 w; w.x = cvt_pk_bf16(v[0] * g[0], v[1] * g[1]); w.y = cvt_pk_bf16(v[2] * g[2], v[3] * g[3]);
                        *(u32x2*)(xg + off + bj * HALF + n * 16) = w; }
                sq += __shfl_xor(sq, 16); sq += __shfl_xor(sq, 32);
                if (fq == 0) atomicAdd(ssq + row, sq); }
    }
};
struct EpiRelu2Norm {
    static constexpr bool PERM = true, MID = false;
    bf16_t* O; int ldc; const float* ssq;
    __device__ __forceinline__ void operator()(const f32x4 (&acc)[2][2][4][2], const Unit& u, int wr, int wc, int fr, int fq) const {
        const int row0 = u.pm * BM + wr * 64 + fr; const int col0 = u.pn * BM + wc * 32 + 8 * fq;
#pragma unroll
        for (int ai = 0; ai < 2; ++ai)
#pragma unroll
            for (int m = 0; m < 4; ++m) { const int row = row0 + ai * HALF + m * 16; bf16_t* rowp = O + (size_t)row * ldc + col0;
                const float r2 = __builtin_amdgcn_rcpf(ssq[row] * (1.0f / D) + EPS);
#pragma unroll
                for (int bj = 0; bj < 2; ++bj) { f32x4 v0 = acc[ai][bj][m][0], v1 = acc[ai][bj][m][1];
#pragma unroll
                    for (int j = 0; j < 4; ++j) { const float a = fmaxf(v0[j], 0.f), b = fmaxf(v1[j], 0.f); v0[j] = a * a * r2; v1[j] = b * b * r2; }
                    u32x4 w; w.x = cvt_pk_bf16(v0[0], v0[1]); w.y = cvt_pk_bf16(v0[2], v0[3]); w.z = cvt_pk_bf16(v1[0], v1[1]); w.w = cvt_pk_bf16(v1[2], v1[3]);
                    *(u32x4*)(rowp + bj * HALF) = w; } }
    }
};
constexpr int GP8 = 17408;
__device__ __forceinline__ float ub0(unsigned w) { return (float)(w & 0xffu); }
__device__ __forceinline__ float ub1(unsigned w) { return (float)((w >> 8) & 0xffu); }
__device__ __forceinline__ float ub2(unsigned w) { return (float)((w >> 16) & 0xffu); }
__device__ __forceinline__ float ub3(unsigned w) { return (float)(w >> 24); }
struct EpiGate8 {
    static constexpr bool PERM = true, MID = false;
    unsigned char* O; const float* bias;
    __device__ __forceinline__ void operator()(const f32x4 (&acc)[2][2][4][2], const Unit& u, int wr, int wc, int fr, int fq) const {
        const int row0 = u.pm * BM + wr * 64 + fr; const int col0 = u.pn * BM + wc * 32 + 8 * fq;
        f32x4 bv[2][2];
#pragma unroll
        for (int bj = 0; bj < 2; ++bj)
#pragma unroll
            for (int n = 0; n < 2; ++n) bv[bj][n] = *(const f32x4*)(bias + col0 + bj * HALF + 4 * n);
#pragma unroll
        for (int ai = 0; ai < 2; ++ai)
#pragma unroll
            for (int m = 0; m < 4; ++m) { unsigned char* rowp = O + (size_t)(row0 + ai * HALF + m * 16) * GP8 + col0;
#pragma unroll
                for (int bj = 0; bj < 2; ++bj) { const f32x4 v0 = acc[ai][bj][m][0] + bv[bj][0], v1 = acc[ai][bj][m][1] + bv[bj][1];
                    unsigned q[8];
#pragma unroll
                    for (int j = 0; j < 4; ++j) { q[j] = (unsigned)fmaxf(__builtin_rintf(sigmoidf_(v0[j]) * 255.f), 1.f); q[4 + j] = (unsigned)fmaxf(__builtin_rintf(sigmoidf_(v1[j]) * 255.f), 1.f); }
                    u32x2 w; w.x = q[0] | (q[1] << 8) | (q[2] << 16) | (q[3] << 24); w.y = q[4] | (q[5] << 8) | (q[6] << 16) | (q[7] << 24);
                    *(u32x2*)(rowp + bj * HALF) = w; } }
    }
};
struct EpiMix {
    static constexpr bool PERM = true, MID = true;
    bf16_t* O; const unsigned char* gates;
    __device__ __forceinline__ bool is_mid(int t) const { return t == 8 || t == 32; }
    __device__ __forceinline__ void mid(f32x4 (&acc)[2][2][4][2], const Unit& u, int wr, int wc, int fr, int fq, int t) const {
        const int offx = (t == 8) ? 0 : 2048;
        const unsigned char* gp0 = gates + (size_t)(u.pm * BM + wr * 64 + fr) * GP8 + u.pn * BM + wc * 32 + 8 * fq + offx;
#pragma unroll
        for (int ai = 0; ai < 2; ++ai) {
            u32x2 gx[4][2], gy[4][2];
#pragma unroll
            for (int m = 0; m < 4; ++m)
#pragma unroll
                for (int bj = 0; bj < 2; ++bj) { const unsigned char* gp = gp0 + (size_t)(ai * HALF + m * 16) * GP8 + bj * HALF; gx[m][bj] = *(const u32x2*)gp; gy[m][bj] = *(const u32x2*)(gp + 2048); }
#pragma unroll
            for (int m = 0; m < 4; ++m)
#pragma unroll
                for (int bj = 0; bj < 2; ++bj) { const u32x2 x = gx[m][bj], y = gy[m][bj];
                    f32x4 r0, r1;
                    r0[0] = __fdividef(ub0(x.x), ub0(y.x)); r0[1] = __fdividef(ub1(x.x), ub1(y.x)); r0[2] = __fdividef(ub2(x.x), ub2(y.x)); r0[3] = __fdividef(ub3(x.x), ub3(y.x));
                    r1[0] = __fdividef(ub0(x.y), ub0(y.y)); r1[1] = __fdividef(ub1(x.y), ub1(y.y)); r1[2] = __fdividef(ub2(x.y), ub2(y.y)); r1[3] = __fdividef(ub3(x.y), ub3(y.y));
                    acc[ai][bj][m][0] *= r0; acc[ai][bj][m][1] *= r1; }
            asm volatile("" ::: "memory"); }
    }
    __device__ __forceinline__ void operator()(const f32x4 (&acc)[2][2][4][2], const Unit& u, int wr, int wc, int fr, int fq) const {
        const int row0 = u.pm * BM + wr * 64 + fr; const int col0 = u.pn * BM + wc * 32 + 8 * fq; const float k = 1.0f / 255.0f;
#pragma unroll
        for (int ai = 0; ai < 2; ++ai)
#pragma unroll
            for (int m = 0; m < 4; ++m) { const size_t row = (size_t)(row0 + ai * HALF + m * 16);
#pragma unroll
                for (int bj = 0; bj < 2; ++bj) { const u32x2 g = *(const u32x2*)(gates + row * GP8 + 4096 + col0 + bj * HALF);
                    const f32x4 v0 = acc[ai][bj][m][0] * k, v1 = acc[ai][bj][m][1] * k;
                    u32x4 w; w.x = cvt_pk_bf16(v0[0] * ub0(g.x), v0[1] * ub1(g.x)); w.y = cvt_pk_bf16(v0[2] * ub2(g.x), v0[3] * ub3(g.x));
                    w.z = cvt_pk_bf16(v1[0] * ub0(g.y), v1[1] * ub1(g.y)); w.w = cvt_pk_bf16(v1[2] * ub2(g.y), v1[3] * ub3(g.y));
                    *(u32x4*)(O + row * D + col0 + bj * HALF) = w; } }
    }
};

template <class Epi, class Sched, bool ALIGN_EPI = true>
__device__ __forceinline__ void gemm_phase(LAS unsigned char* lds, const Gemm g, const Sched& S, const Epi& E) {
    const int tid = threadIdx.x, wid = __builtin_amdgcn_readfirstlane(tid >> 6), lane = tid & 63, wr = wid >> 2, wc = wid & 3, fr = lane & 15, fq = lane >> 4;
    const int K = g.K, nt = K / BK;
    unsigned voffA[2], voffB[2];
#pragma unroll
    for (int i = 0; i < 2; ++i) { int R, C; stage_rc(tid * 16 + i * 8192, R, C); const int Rb = Epi::PERM ? ((R & ~31) + perm32(R & 31)) : R;
        voffA[i] = (unsigned)(R * g.lda + C) * 2u; voffB[i] = (unsigned)(Rb * g.ldb + C) * 2u; }
    const size_t kstep = (size_t)(BK * 2);
    const size_t hstepA = (size_t)HALF * g.lda * 2, hstepB = (size_t)HALF * g.ldb * 2;
    const size_t tstepA = 2 * hstepA, tstepB = 2 * hstepB;
    const unsigned ldsw = (unsigned)wid * 1024u;
    const int aoff = lds_byte(wr * 64 + fr, fq * 8), boff = lds_byte(wc * 32 + fr, fq * 8);
#define PG8_SA(b, h) (((b) * 2 + (h)) * HTB)
#define PG8_SB(b, h) ((4 + (b) * 2 + (h)) * HTB)
#define PG8_STAGE(bufoff, gbase, voff) do { _Pragma("unroll") for (int _i = 0; _i < 2; ++_i) \
        __builtin_amdgcn_global_load_lds((const unsigned*)((const char*)(gbase) + (voff)[_i]), (LAS unsigned*)(lds + (bufoff) + ldsw + _i * 8192), 16, 0, 0); } while (0)
#define PG8_LDA(dst, b, h) do { _Pragma("unroll") for (int m = 0; m < 4; ++m) _Pragma("unroll") for (int k = 0; k < 2; ++k) dst[m][k] = *(const LAS bf16x8*)(lds + PG8_SA(b, h) + aoff + m * 2048 + k * 1024); } while (0)
#define PG8_LDB(dst, b, h) do { _Pragma("unroll") for (int n = 0; n < 2; ++n) _Pragma("unroll") for (int k = 0; k < 2; ++k) dst[n][k] = *(const LAS bf16x8*)(lds + PG8_SB(b, h) + boff + n * 2048 + k * 1024); } while (0)
#define PG8_MMA(ai, bj, At, Bt) do { __builtin_amdgcn_s_setprio(1); _Pragma("unroll") for (int m = 0; m < 4; ++m) _Pragma("unroll") for (int n = 0; n < 2; ++n) _Pragma("unroll") for (int k = 0; k < 2; ++k) \
        acc[ai][bj][m][n] = __builtin_amdgcn_mfma_f32_16x16x32_bf16(Bt[n][k], At[m][k], acc[ai][bj][m][n], 0, 0, 0); __builtin_amdgcn_s_setprio(0); } while (0)
#define PG8_WAIT_V(n) asm volatile("s_waitcnt vmcnt(" #n ")" ::: "memory")
#define PG8_WAIT_L(n) asm volatile("s_waitcnt lgkmcnt(" #n ")" ::: "memory")
#define PG8_BAR __builtin_amdgcn_s_barrier()
#define PG8_SCHED __builtin_amdgcn_sched_barrier(0)
    Unit cur, nxt; int ui = 0;
    if (!S.next(0, cur)) return;
    f32x4 acc[2][2][4][2];
#pragma unroll
    for (int a = 0; a < 2; ++a)
#pragma unroll
        for (int b = 0; b < 2; ++b)
#pragma unroll
            for (int m = 0; m < 4; ++m)
#pragma unroll
                for (int n = 0; n < 2; ++n) acc[a][b][m][n] = (f32x4){0.f, 0.f, 0.f, 0.f};
    bf16x8 At[4][2], B0[2][2], B1[2][2];
    const char* cA = (const char*)g.A + (size_t)cur.pm * tstepA; const char* cB = (const char*)g.Bt + (size_t)cur.pn * tstepB;
    PG8_STAGE(PG8_SB(0, 0), cB, voffB); PG8_STAGE(PG8_SB(0, 1), cB + hstepB, voffB); PG8_STAGE(PG8_SA(0, 0), cA, voffA); PG8_STAGE(PG8_SA(0, 1), cA + hstepA, voffA);
    if (wr == 1) PG8_BAR;
    PG8_WAIT_V(2); PG8_BAR;
    PG8_STAGE(PG8_SB(1, 0), cB + kstep, voffB); PG8_STAGE(PG8_SA(1, 0), cA + kstep, voffA); PG8_STAGE(PG8_SB(1, 1), cB + hstepB + kstep, voffB);
    PG8_WAIT_V(6); PG8_BAR;
    for (;;) {
        const bool has_next = S.next(ui + 1, nxt);
        const char* nA = has_next ? (const char*)g.A + (size_t)nxt.pm * tstepA : cA; const char* nB = has_next ? (const char*)g.Bt + (size_t)nxt.pn * tstepB : cB;
        for (int t = 0; t < nt; t += 2) {
            const bool last = (t == nt - 2);
            const char* a1 = cA + (size_t)(t + 1) * kstep;
            const char* a2 = last ? nA : cA + (size_t)(t + 2) * kstep; const char* b2 = last ? nB : cB + (size_t)(t + 2) * kstep;
            const char* a3 = a2 + kstep; const char* b3 = b2 + kstep;
            PG8_LDB(B0, 0, 0); PG8_LDB(B1, 0, 1); PG8_SCHED; PG8_LDA(At, 0, 0); PG8_STAGE(PG8_SA(1, 1), a1 + hstepA, voffA);
            PG8_WAIT_V(8); PG8_WAIT_L(0); PG8_BAR; PG8_MMA(0, 0, At, B0); PG8_MMA(0, 1, At, B1); PG8_BAR; PG8_SCHED;
            PG8_LDA(At, 0, 1); PG8_STAGE(PG8_SB(0, 0), b2, voffB); PG8_STAGE(PG8_SB(0, 1), b2 + hstepB, voffB); PG8_STAGE(PG8_SA(0, 0), a2, voffA);
            PG8_WAIT_V(8); PG8_WAIT_L(0); PG8_BAR; PG8_MMA(1, 0, At, B0); PG8_MMA(1, 1, At, B1); PG8_BAR; PG8_SCHED;
            PG8_LDB(B0, 1, 0); PG8_LDB(B1, 1, 1); PG8_SCHED; PG8_LDA(At, 1, 0); PG8_STAGE(PG8_SA(0, 1), a2 + hstepA, voffA);
            PG8_WAIT_V(8); PG8_WAIT_L(0); PG8_BAR; PG8_MMA(0, 0, At, B0); PG8_MMA(0, 1, At, B1); PG8_BAR; PG8_SCHED;
            PG8_LDA(At, 1, 1); PG8_STAGE(PG8_SB(1, 0), b3, voffB); PG8_STAGE(PG8_SB(1, 1), b3 + hstepB, voffB); PG8_STAGE(PG8_SA(1, 0), a3, voffA);
            PG8_WAIT_V(8); PG8_WAIT_L(0); PG8_BAR; PG8_MMA(1, 0, At, B0); PG8_MMA(1, 1, At, B1); PG8_BAR; PG8_SCHED;
            if constexpr (Epi::MID) { if (E.is_mid(t + 2)) { E.mid(acc, cur, wr, wc, fr, fq, t + 2); PG8_SCHED; } }
        }
        if constexpr (ALIGN_EPI) { if (wr == 0) PG8_BAR; }
        E(acc, cur, wr, wc, fr, fq);
        if (!has_next) break;
#pragma unroll
        for (int a = 0; a < 2; ++a)
#pragma unroll
            for (int b = 0; b < 2; ++b)
#pragma unroll
                for (int m = 0; m < 4; ++m)
#pragma unroll
                    for (int n = 0; n < 2; ++n) acc[a][b][m][n] = (f32x4){0.f, 0.f, 0.f, 0.f};
        cur = nxt; cA = nA; cB = nB; ++ui;
        if constexpr (ALIGN_EPI) { if (wr == 1) PG8_BAR; }
    }
    PG8_WAIT_V(0);
    if constexpr (!ALIGN_EPI) { if (wr == 0) PG8_BAR; }
    PG8_BAR;
#undef PG8_SA
#undef PG8_SB
#undef PG8_STAGE
#undef PG8_LDA
#undef PG8_LDB
#undef PG8_MMA
#undef PG8_WAIT_V
#undef PG8_WAIT_L
#undef PG8_BAR
#undef PG8_SCHED
}
}

struct Args {
    const float *x, *mem, *rel_bias, *norm_mix, *norm_mem, *norm_mlp, *norm_final, *w_in, *w_gate, *b_gate, *conv_w, *conv_b,
                *lru_wa, *lru_ba, *lru_wi, *lru_bi, *lru_lambda, *w_mem_kv, *w_o_attn, *w_o_lru, *w_o_mem, *w_out, *w_up, *w_down;
    float* out; unsigned char* ws; int ph_lo, ph_hi;
};

struct Frame { LAS unsigned char* lds; int tid, lane, wave, G, bid; };

__device__ __forceinline__ void p0_transpose_item(const float* W, int N, bf16_t* WT, int ldt, int coff, LAS float* scr, int item, int lane) {
    const int nblk = N / 32, kb = item / nblk, nb = item % nblk, k0 = 64 * kb, n0 = 32 * nb;
    { f32x4 v[8];
#pragma unroll
      for (int i = 0; i < 8; ++i) v[i] = *(const f32x4*)(W + (size_t)(k0 + 8 * i + (lane >> 3)) * N + n0 + 4 * (lane & 7));
#pragma unroll
      for (int i = 0; i < 8; ++i) { LAS float* d = scr + (8 * i + (lane >> 3)) * 33 + 4 * (lane & 7); d[0] = v[i].x; d[1] = v[i].y; d[2] = v[i].z; d[3] = v[i].w; } }
    asm volatile("s_waitcnt lgkmcnt(0)" ::: "memory");
    const int c = lane & 7;
#pragma unroll
    for (int j = 0; j < 4; ++j) { const int n = (lane >> 3) + 8 * j; const LAS float* s = scr + (8 * c) * 33 + n;
        u32x4 o; o.x = cvt_pk_bf16(s[0 * 33], s[1 * 33]); o.y = cvt_pk_bf16(s[2 * 33], s[3 * 33]); o.z = cvt_pk_bf16(s[4 * 33], s[5 * 33]); o.w = cvt_pk_bf16(s[6 * 33], s[7 * 33]);
        *(u32x4*)(WT + (size_t)(n0 + n) * ldt + coff + k0 + 8 * c) = o; }
    asm volatile("s_waitcnt lgkmcnt(0)" ::: "memory");
}
__device__ __forceinline__ void rms_row_bf16(const float* xrow, const float* gain, bf16_t* orow, int lane) {
    const f32x4* xr = (const f32x4*)xrow + lane; const f32x4* gr = (const f32x4*)gain + lane;
    f32x4 v[8]; float s = 0.f;
#pragma unroll
    for (int j = 0; j < 8; ++j) { v[j] = xr[64 * j]; s += (v[j].x * v[j].x + v[j].y * v[j].y) + (v[j].z * v[j].z + v[j].w * v[j].w); }
    const float rs = rsqrtf(wave_sum(s) * (1.f / D) + EPS);
    u32x2* o8 = (u32x2*)orow + lane;
#pragma unroll
    for (int j = 0; j < 8; ++j) { const f32x4 g = gr[64 * j]; u32x2 w; w.x = cvt_pk_bf16(v[j].x * rs * g.x, v[j].y * rs * g.y); w.y = cvt_pk_bf16(v[j].z * rs * g.z, v[j].w * rs * g.w); o8[64 * j] = w; }
}
__device__ __forceinline__ void rms_row_f32(float* xrow, const float* gain, int lane) {
    f32x4* xr = (f32x4*)xrow + lane; const f32x4* gr = (const f32x4*)gain + lane;
    f32x4 v[8]; float s = 0.f;
#pragma unroll
    for (int j = 0; j < 8; ++j) { v[j] = xr[64 * j]; s += (v[j].x * v[j].x + v[j].y * v[j].y) + (v[j].z * v[j].z + v[j].w * v[j].w); }
    const float rs = rsqrtf(wave_sum(s) * (1.f / D) + EPS);
#pragma unroll
    for (int j = 0; j < 8; ++j) { const f32x4 g = gr[64 * j]; xr[64 * j] = v[j] * rs * g; }
}

__device__ __forceinline__ void rms_row_add_bf16(const float* xrow, const bf16_t* mrow, const float* gain, bf16_t* orow, int lane) {
    const f32x4* xr = (const f32x4*)xrow + lane; const u32x2* mr = (const u32x2*)mrow + lane; const f32x4* gr = (const f32x4*)gain + lane;
    f32x4 v[8]; float s = 0.f;
#pragma unroll
    for (int j = 0; j < 8; ++j) { const u32x2 mm = mr[64 * j]; v[j] = xr[64 * j]; v[j].x += bflo(mm.x); v[j].y += bfhi(mm.x); v[j].z += bflo(mm.y); v[j].w += bfhi(mm.y);
        s += (v[j].x * v[j].x + v[j].y * v[j].y) + (v[j].z * v[j].z + v[j].w * v[j].w); }
    const float rs = rsqrtf(wave_sum(s) * (1.f / D) + EPS);
    u32x2* o8 = (u32x2*)orow + lane;
#pragma unroll
    for (int j = 0; j < 8; ++j) { const f32x4 g = gr[64 * j]; u32x2 w; w.x = cvt_pk_bf16(v[j].x * rs * g.x, v[j].y * rs * g.y); w.y = cvt_pk_bf16(v[j].z * rs * g.z, v[j].w * rs * g.w); o8[64 * j] = w; }
}
__device__ __forceinline__ void rms_row_final(const float* xrow, const bf16_t* mrow, const bf16_t* drow, const float* gain, float* orow, int lane) {
    const f32x4* xr = (const f32x4*)xrow + lane; const u32x2* mr = (const u32x2*)mrow + lane; const u32x2* dr = (const u32x2*)drow + lane; const f32x4* gr = (const f32x4*)gain + lane;
    f32x4 v[8]; float s = 0.f;
#pragma unroll
    for (int j = 0; j < 8; ++j) { const u32x2 mm = mr[64 * j], dd = dr[64 * j]; v[j] = xr[64 * j];
        v[j].x += bflo(mm.x) + bflo(dd.x); v[j].y += bfhi(mm.x) + bfhi(dd.x); v[j].z += bflo(mm.y) + bflo(dd.y); v[j].w += bfhi(mm.y) + bfhi(dd.y);
        s += (v[j].x * v[j].x + v[j].y * v[j].y) + (v[j].z * v[j].z + v[j].w * v[j].w); }
    const float rs = rsqrtf(wave_sum(s) * (1.f / D) + EPS);
    f32x4* o = (f32x4*)orow + lane;
#pragma unroll
    for (int j = 0; j < 8; ++j) { const f32x4 g = gr[64 * j]; o[64 * j] = v[j] * rs * g; }
}

struct TrJob { const float* W; int K, N; bf16_t* WT; int ldt, coff; };

__device__ __forceinline__ void phase0(const Frame& F, const Args& a) {
    unsigned char* ws = a.ws;
    LAS float* scr = (LAS float*)(F.lds + F.wave * 16384);
    const int gw = F.bid * 8 + F.wave, NGW = F.G * 8;
    {
        int base = 0;
#define TR(Wp, K_, N_, WTp, ldt_, coff_) { const int ni = ((K_) / 64) * ((N_) / 32); int first = ((gw - base) % NGW + NGW) % NGW; \
            for (int it = first; it < ni; it += NGW) p0_transpose_item((Wp), (N_), (bf16_t*)(WTp), (ldt_), (coff_), scr, it, F.lane); base = (base + ni) % NGW; }
        TR(a.w_in, D, NIN, ws + WS_WIN, D, 0)
        TR(a.w_gate, D, NG, ws + WS_WGATE, D, 0)
        TR(a.w_mem_kv, D, 2048, ws + WS_WMKV, D, 0)
        TR(a.w_o_attn, 512, D, ws + WS_WO, YP, 0)
        TR(a.w_o_lru, 1536, D, ws + WS_WO, YP, 512)
        TR(a.w_o_mem, 1024, D, ws + WS_WO, YP, 2048)
        TR(a.w_out, D, D, ws + WS_WOUT, D, 0)
        TR(a.w_up, D, DFF, ws + WS_WUP, D, 0)
        TR(a.w_down, DFF, D, ws + WS_WDN, DFF, 0)
#undef TR
        for (int it = gw; it < 48 * 8; it += NGW) { const int mat = it >> 3, sub = it & 7; const int which = mat / 24, dn = mat % 24;
            const float* W = (which ? a.lru_wi : a.lru_wa) + (size_t)dn * 16384;
            p0_transpose_item(W, 128, (bf16_t*)(ws + WS_WLRU) + (size_t)(dn * 2 + which) * 16384, 128, 0, scr, sub, F.lane); }
    }
    for (int m = gw; m < M; m += NGW) rms_row_bf16(a.x + (size_t)m * D, a.norm_mix, (bf16_t*)(ws + WS_H) + (size_t)m * D, F.lane);
    for (int m = gw; m < BATCH * NMEM; m += NGW) rms_row_bf16(a.mem + (size_t)m * D, a.norm_mem, (bf16_t*)(ws + WS_MEMN) + (size_t)m * D, F.lane);
    if (F.bid == 1) { for (int i = F.tid; i < M; i += 512) ((float*)(ws + WS_SSQ))[i] = 0.f; }
    if (F.bid == 0) {
        for (int i = F.tid; i < 12 * 129; i += 512) { const int h = i / 129, rel = i % 129 - 64; const int g = h >> 2, d = (g == 0) ? 1 : (g == 1 ? 4 : 16);
            const int off = rel * d; const int n = off < 0 ? -off : off; int bucket = (off > 0) ? 16 : 0;
            if (n < 8) bucket += n; else { int large = 8 + (int)(log((double)n / 8.0) / log(128.0) * 8.0); if (large > 15) large = 15; bucket += large; }
            ((float*)(ws + WS_TAB))[h * 132 + rel + 64] = a.rel_bias[bucket * 12 + h]; }
    }
}

constexpr int AT_PITCH = 272, AT_R1 = 69632, AT_TAB = 139264;
__device__ __forceinline__ s16x4 vtr(const LAS char* p) { return __builtin_bit_cast(s16x4, __builtin_amdgcn_ds_read_tr16_b64_v4i16((LAS s16x4*)p)); }

template <int NCT>
__device__ __forceinline__ void qk_accum(f32x4 (&s)[NCT], const LAS unsigned char* Kt, int key_row0, const bf16x8 (&qf)[4], int fr, int fq) {
#pragma unroll
    for (int ct = 0; ct < NCT; ++ct)
#pragma unroll
        for (int ks = 0; ks < 4; ++ks) { const bf16x8 kf = *(const LAS bf16x8*)(Kt + (key_row0 + 16 * ct + fr) * AT_PITCH + 64 * ks + 16 * fq);
            s[ct] = __builtin_amdgcn_mfma_f32_16x16x32_bf16(kf, qf[ks], s[ct], 0, 0, 0); if (ks == 3 && (ct & 1)) asm volatile("" ::: "memory"); }
}
template <int NKS>
__device__ __forceinline__ void pv_accum(f32x4 (&o)[8], const LAS unsigned char* Vt, int key_row0, const bf16x8 (&pf)[NKS], int fr, int fq) {
#pragma unroll
    for (int ks = 0; ks < NKS; ++ks) {
        const LAS char* p0 = (const LAS char*)Vt + (key_row0 + 32 * ks + 4 * fq + (fr >> 2)) * AT_PITCH + 8 * (fr & 3);
#pragma unroll
        for (int dt = 0; dt < 8; ++dt) { const s16x4 lo = vtr(p0 + 32 * dt), hi = vtr(p0 + 16 * AT_PITCH + 32 * dt);
            const bf16x8 vf = {lo[0], lo[1], lo[2], lo[3], hi[0], hi[1], hi[2], hi[3]};
            o[dt] = __builtin_amdgcn_mfma_f32_16x16x32_bf16(vf, pf[ks], o[dt], 0, 0, 0); }
        asm volatile("" ::: "memory");
    }
}
#define STAGE_TILE(REG, ROWPTR_EXPR) do { _Pragma("unroll") for (int _it = 0; _it < 8; ++_it) { const int _idx = F.tid + 512 * _it; const int i = _idx >> 4, _ch = _idx & 15; \
        const bf16_t* _rp = (ROWPTR_EXPR); u32x4 _v = (u32x4){0u, 0u, 0u, 0u}; if (_rp) _v = *(const u32x4*)(_rp + 8 * _ch); *(LAS u32x4*)((REG) + i * AT_PITCH + 16 * _ch) = _v; } } while (0)

#define STAGE_TILE2(REGA, ROWPTR_A, REGB, ROWPTR_B) do { u32x4 _va[8], _vb[8]; \
        _Pragma("unroll") for (int _it = 0; _it < 8; ++_it) { const int _idx = F.tid + 512 * _it; const int i = _idx >> 4, _ch = _idx & 15; \
            const bf16_t* _rpa = (ROWPTR_A); const bf16_t* _rpb = (ROWPTR_B); _va[_it] = (u32x4){0u, 0u, 0u, 0u}; _vb[_it] = (u32x4){0u, 0u, 0u, 0u}; \
            if (_rpa) _va[_it] = *(const u32x4*)(_rpa + 8 * _ch); if (_rpb) _vb[_it] = *(const u32x4*)(_rpb + 8 * _ch); } \
        _Pragma("unroll") for (int _it = 0; _it < 8; ++_it) { const int _idx = F.tid + 512 * _it; const int i = _idx >> 4, _ch = _idx & 15; \
            *(LAS u32x4*)((REGA) + i * AT_PITCH + 16 * _ch) = _va[_it]; *(LAS u32x4*)((REGB) + i * AT_PITCH + 16 * _ch) = _vb[_it]; } } while (0)

__device__ __forceinline__ void attnA_item(const Frame& F, const Args& a, int item) {
    const bf16_t* proj = (const bf16_t*)(a.ws + WS_PROJ);
    const int b = item / 384, rem = item % 384, h = rem >> 5, q = rem & 31, g = h >> 2, hh = h & 3;
    const int dsh = 2 * g, d = 1 << dsh, L = SEQ >> dsh, npairs = 32 >> dsh, r = q / npairs, n0 = 2 * (q % npairs);
    const int fr = F.lane & 15, fq = F.lane >> 4, hb = F.wave >> 2;
    const size_t rowbase = (size_t)b * SEQ;
    const int kp0 = (n0 - 1) * 64;
    LAS unsigned char* R0 = F.lds; LAS unsigned char* R1 = F.lds + AT_R1; LAS float* tab = (LAS float*)(F.lds + AT_TAB);
    __syncthreads();
    STAGE_TILE2(R0, ((kp0 + i >= 0 && kp0 + i < L) ? proj + (rowbase + (size_t)(kp0 + i) * d + r) * NIN + C_K + h * 128 : (const bf16_t*)nullptr),
                R1, ((kp0 + i >= 0 && kp0 + i < L) ? proj + (rowbase + (size_t)(kp0 + i) * d + r) * NIN + C_V + h * 128 : (const bf16_t*)nullptr));
    if (F.tid < 129) tab[F.tid] = ((const float*)(a.ws + WS_TAB))[h * 132 + F.tid];
    const int qq = 16 * (F.wave & 3) + fr;
    const int qpos = (n0 + hb) * 64 + qq;
    const size_t qrow = rowbase + (size_t)qpos * d + r;
    bf16x8 qf[4];
#pragma unroll
    for (int ks = 0; ks < 4; ++ks) qf[ks] = *(const bf16x8*)(proj + qrow * NIN + C_Q + h * 128 + 32 * ks + 8 * fq);
    __syncthreads();
    f32x4 s[12];
#pragma unroll
    for (int ct = 0; ct < 12; ++ct) s[ct] = (f32x4){0.f, 0.f, 0.f, 0.f};
    qk_accum<12>(s, R0, 64 * hb, qf, fr, fq);
    const float scale = 0.08838834764831845f;
    const int kpw = (n0 + hb - 1) * 64;
    float mx = -3.0e38f;
#pragma unroll
    for (int ct = 0; ct < 12; ++ct)
#pragma unroll
        for (int j = 0; j < 4; ++j) { const int kk = 16 * ct + 4 * fq + j; const int rel = kk - 64 - qq; const int kp = kpw + kk;
            const bool valid = (rel >= -64) && (rel <= 64) && (kp >= 0) && (kp < L);
            const float bias = tab[valid ? rel + 64 : 64];
            const float l = valid ? s[ct][j] * scale + bias : -1e30f; s[ct][j] = l; mx = fmaxf(mx, l); }
    mx = fmaxf(mx, __shfl_xor(mx, 16)); mx = fmaxf(mx, __shfl_xor(mx, 32));
    float sum = 0.f;
#pragma unroll
    for (int ct = 0; ct < 12; ++ct)
#pragma unroll
        for (int j = 0; j < 4; ++j) { const float p = __expf(s[ct][j] - mx); s[ct][j] = p; sum += p; }
    sum += __shfl_xor(sum, 16); sum += __shfl_xor(sum, 32);
    bf16x8 pf[6];
#pragma unroll
    for (int ks = 0; ks < 6; ++ks) { u32x4 w; w.x = cvt_pk_bf16(s[2 * ks][0], s[2 * ks][1]); w.y = cvt_pk_bf16(s[2 * ks][2], s[2 * ks][3]);
        w.z = cvt_pk_bf16(s[2 * ks + 1][0], s[2 * ks + 1][1]); w.w = cvt_pk_bf16(s[2 * ks + 1][2], s[2 * ks + 1][3]); pf[ks] = __builtin_bit_cast(bf16x8, w); }
    f32x4 o[8];
#pragma unroll
    for (int dt = 0; dt < 8; ++dt) o[dt] = (f32x4){0.f, 0.f, 0.f, 0.f};
    pv_accum<6>(o, R1, 64 * hb, pf, fr, fq);
    const float inv = 1.0f / sum;
    bf16_t* orow = (g == 0) ? (bf16_t*)a.out + qrow * YP + hh * 128 : (bf16_t*)((unsigned char*)a.out + DO_O12) + qrow * 1024 + (g - 1) * 512 + hh * 128;
#pragma unroll
    for (int dt = 0; dt < 8; ++dt) { u32x2 w; w.x = cvt_pk_bf16(o[dt][0] * inv, o[dt][1] * inv); w.y = cvt_pk_bf16(o[dt][2] * inv, o[dt][3] * inv); *(u32x2*)(orow + 16 * dt + 4 * fq) = w; }
    if (fq == 0) ((float*)(a.ws + WS_LSE))[qrow * 12 + h] = mx + __logf(sum);
}

__device__ __forceinline__ void attnC_item(const Frame& F, const Args& a, int item) {
    const bf16_t* proj = (const bf16_t*)(a.ws + WS_PROJ); const bf16_t* kv = (const bf16_t*)(a.ws + WS_KV);
    const int b = item >> 7, head = (item >> 5) & 3, qb = item & 31;
    const int fr = F.lane & 15, fq = F.lane >> 4;
    LAS unsigned char* R0 = F.lds; LAS unsigned char* R1 = F.lds + AT_R1;
    const size_t qrow = (size_t)b * SEQ + qb * 128 + 16 * F.wave + fr;
    const bf16_t* kbase = kv + (size_t)b * NMEM * 2048 + head * 256;
    __syncthreads();
    STAGE_TILE2(R0, (kbase + (size_t)i * 2048), R1, (kbase + (size_t)i * 2048 + 128));
    bf16x8 qf[4];
    f32x4 s[16];
#pragma unroll
    for (int ct = 0; ct < 16; ++ct) s[ct] = (f32x4){0.f, 0.f, 0.f, 0.f};
#pragma unroll
    for (int ks = 0; ks < 4; ++ks) qf[ks] = *(const bf16x8*)(proj + qrow * NIN + C_QC + head * 256 + 32 * ks + 8 * fq);
    __syncthreads();
    qk_accum<16>(s, R0, 0, qf, fr, fq);
#pragma unroll
    for (int ks = 0; ks < 4; ++ks) qf[ks] = *(const bf16x8*)(proj + qrow * NIN + C_QC + head * 256 + 128 + 32 * ks + 8 * fq);
    qk_accum<16>(s, R1, 0, qf, fr, fq);
    float mx = -3.0e38f;
#pragma unroll
    for (int ct = 0; ct < 16; ++ct)
#pragma unroll
        for (int j = 0; j < 4; ++j) { const float l = s[ct][j] * 0.0625f; s[ct][j] = l; mx = fmaxf(mx, l); }
    mx = fmaxf(mx, __shfl_xor(mx, 16)); mx = fmaxf(mx, __shfl_xor(mx, 32));
    float sum = 0.f;
#pragma unroll
    for (int ct = 0; ct < 16; ++ct)
#pragma unroll
        for (int j = 0; j < 4; ++j) { const float p = __expf(s[ct][j] - mx); s[ct][j] = p; sum += p; }
    sum += __shfl_xor(sum, 16); sum += __shfl_xor(sum, 32);
    bf16x8 pf[8];
#pragma unroll
    for (int ks = 0; ks < 8; ++ks) { u32x4 w; w.x = cvt_pk_bf16(s[2 * ks][0], s[2 * ks][1]); w.y = cvt_pk_bf16(s[2 * ks][2], s[2 * ks][3]);
        w.z = cvt_pk_bf16(s[2 * ks + 1][0], s[2 * ks + 1][1]); w.w = cvt_pk_bf16(s[2 * ks + 1][2], s[2 * ks + 1][3]); pf[ks] = __builtin_bit_cast(bf16x8, w); }
    __syncthreads();
    STAGE_TILE2(R0, (kbase + (size_t)i * 2048 + 1024), R1, (kbase + (size_t)i * 2048 + 1024 + 128));
    __syncthreads();
    const float inv = 1.0f / sum;
    bf16_t* orow = (bf16_t*)a.out + qrow * YP + 2048 + head * 256;
#pragma unroll
    for (int half = 0; half < 2; ++half) {
        f32x4 o[8];
#pragma unroll
        for (int dt = 0; dt < 8; ++dt) o[dt] = (f32x4){0.f, 0.f, 0.f, 0.f};
        pv_accum<8>(o, half ? R1 : R0, 0, pf, fr, fq);
#pragma unroll
        for (int dt = 0; dt < 8; ++dt) { u32x2 w; w.x = cvt_pk_bf16(o[dt][0] * inv, o[dt][1] * inv); w.y = cvt_pk_bf16(o[dt][2] * inv, o[dt][3] * inv); *(u32x2*)(orow + 128 * half + 16 * dt + 4 * fq) = w; }
    }
}

__device__ __forceinline__ void combine_row(const Args& a, size_t row, int lane) {
    bf16_t* y = (bf16_t*)a.out + row * YP + 8 * lane; const bf16_t* o12 = (const bf16_t*)((unsigned char*)a.out + DO_O12) + row * 1024 + 8 * lane;
    const float* lse = (const float*)(a.ws + WS_LSE) + row * 12; const int hh = lane >> 4;
    const float l0 = lse[hh], l1 = lse[4 + hh], l2 = lse[8 + hh]; const float mx = fmaxf(l0, fmaxf(l1, l2));
    float w0 = __expf(l0 - mx), w1 = __expf(l1 - mx), w2 = __expf(l2 - mx); const float inv = 1.0f / (w0 + w1 + w2); w0 *= inv; w1 *= inv; w2 *= inv;
    const u32x4 v0 = *(const u32x4*)y, v1 = *(const u32x4*)o12, v2 = *(const u32x4*)(o12 + 512);
    u32x4 w;
    w.x = cvt_pk_bf16(w0 * bflo(v0.x) + w1 * bflo(v1.x) + w2 * bflo(v2.x), w0 * bfhi(v0.x) + w1 * bfhi(v1.x) + w2 * bfhi(v2.x));
    w.y = cvt_pk_bf16(w0 * bflo(v0.y) + w1 * bflo(v1.y) + w2 * bflo(v2.y), w0 * bfhi(v0.y) + w1 * bfhi(v1.y) + w2 * bfhi(v2.y));
    w.z = cvt_pk_bf16(w0 * bflo(v0.z) + w1 * bflo(v1.z) + w2 * bflo(v2.z), w0 * bfhi(v0.z) + w1 * bfhi(v1.z) + w2 * bfhi(v2.z));
    w.w = cvt_pk_bf16(w0 * bflo(v0.w) + w1 * bflo(v1.w) + w2 * bflo(v2.w), w0 * bfhi(v0.w) + w1 * bfhi(v1.w) + w2 * bfhi(v2.w));
    *(u32x4*)y = w;
}

constexpr int LR_AT = 70656;
__device__ __forceinline__ int lru_perm(int t) { return (t & ~63) | ((t & 12) << 2) | ((t & 48) >> 2) | (t & 3); }
__device__ __forceinline__ float fsig(float x) { return __builtin_amdgcn_rcpf(1.0f + __expf(-x)); }
template <bool PASS2>
__device__ __forceinline__ void lru_item(const Frame& F, const Args& a, int item) {
    const bf16_t* proj = (const bf16_t*)(a.ws + WS_PROJ);
    const int n = item % 12, chunk = (item / 12) % NCHUNK, b = item / (12 * NCHUNK);
    const int t0 = chunk * CHUNK; const size_t rowbase = (size_t)b * SEQ;
    const int fr = F.lane & 15, fq = F.lane >> 4, w = F.wave;
    const int c = 16 * w + fr, cg_ = n * 128 + c;
    const int cch = F.tid & 15, r0 = F.tid >> 4;
    LAS unsigned char* R0 = F.lds; LAS unsigned char* AT = F.lds + LR_AT;
    __syncthreads();
    for (int idx = F.tid; idx < 259 * 16; idx += 512) { const int row = idx >> 4, ch = idx & 15; const int t = t0 - 1 + row; u32x4 v = (u32x4){0u, 0u, 0u, 0u};
        if (t >= 0 && t < SEQ) v = *(const u32x4*)(proj + (rowbase + t) * NIN + C_XB + n * 128 + 8 * ch);
        *(LAS u32x4*)(R0 + row * AT_PITCH + 16 * ch) = v; }
    {
        f32x4 cw[4][2], cbv[2];
#pragma unroll
        for (int j = 0; j < 4; ++j) { cw[j][0] = *(const f32x4*)(a.conv_w + j * 1536 + n * 128 + 8 * cch); cw[j][1] = *(const f32x4*)(a.conv_w + j * 1536 + n * 128 + 8 * cch + 4); }
        cbv[0] = *(const f32x4*)(a.conv_b + n * 128 + 8 * cch); cbv[1] = *(const f32x4*)(a.conv_b + n * 128 + 8 * cch + 4);
        u32x4 ybv[8];
        if (PASS2) {
#pragma unroll
            for (int it = 0; it < 8; ++it) ybv[it] = *(const u32x4*)(proj + (rowbase + t0 + r0 + 32 * it) * NIN + C_YB + n * 128 + 8 * cch);
        }
        __syncthreads();
#pragma unroll 2
        for (int it = 0; it < 8; ++it) { const int tl = r0 + 32 * it;
            f32x4 x0 = cbv[0], x1 = cbv[1];
#pragma unroll
            for (int j = 0; j < 4; ++j) { const u32x4 v = *(const LAS u32x4*)(R0 + (tl + j) * AT_PITCH + 16 * cch);
                x0[0] += cw[j][0][0] * bflo(v.x); x0[1] += cw[j][0][1] * bfhi(v.x); x0[2] += cw[j][0][2] * bflo(v.y); x0[3] += cw[j][0][3] * bfhi(v.y);
                x1[0] += cw[j][1][0] * bflo(v.z); x1[1] += cw[j][1][1] * bfhi(v.z); x1[2] += cw[j][1][2] * bflo(v.w); x1[3] += cw[j][1][3] * bfhi(v.w); }
            u32x4 o; o.x = cvt_pk_bf16(x0[0], x0[1]); o.y = cvt_pk_bf16(x0[2], x0[3]); o.z = cvt_pk_bf16(x1[0], x1[1]); o.w = cvt_pk_bf16(x1[2], x1[3]);
            *(LAS u32x4*)(AT + lru_perm(tl) * AT_PITCH + 16 * cch) = o; }
        __syncthreads();
        if (PASS2) {
#pragma unroll
            for (int it = 0; it < 8; ++it) *(LAS u32x4*)(R0 + (r0 + 32 * it) * AT_PITCH + 16 * cch) = ybv[it];
        }
    }
    bf16x8 sel;
    { const bool mine = (fq == 2 * (w & 1) + (fr >> 3));
#pragma unroll
      for (int jj = 0; jj < 8; ++jj) sel[jj] = (mine && jj == (fr & 7)) ? (short)0x3F80 : (short)0; }
    const int ks0 = w >> 1;
    float hf[4][4][4];
#pragma unroll
    for (int i0 = 0; i0 < 4; ++i0)
#pragma unroll
        for (int i1 = 0; i1 < 4; ++i1)
#pragma unroll
            for (int i2 = 0; i2 < 4; ++i2) hf[i0][i1][i2] = 0.f;
    auto dir_body = [&](auto dirc) __attribute__((always_inline)) { constexpr int dir = decltype(dirc)::value;
        const bf16_t* wt = (const bf16_t*)(a.ws + WS_WLRU) + (size_t)((dir * 12 + n) * 2) * 16384 + (size_t)c * 128 + 8 * fq;
        bf16x8 wrf[4], wif[4];
#pragma unroll
        for (int ks = 0; ks < 4; ++ks) { wrf[ks] = *(const bf16x8*)(wt + 32 * ks); wif[ks] = *(const bf16x8*)(wt + 16384 + 32 * ks); }
        const float ba = a.lru_ba[dir * 1536 + cg_], bi = a.lru_bi[dir * 1536 + cg_];
        const float lam = a.lru_lambda[dir * 1536 + cg_];
        const float logu = -8.0f * log1pf(__expf(-lam));
        float hc = 0.f, TA = 1.f, TB = 0.f;
        if (PASS2) { const f32x2* ag = (const f32x2*)(a.ws + WS_AGG) + ((size_t)(b * NCHUNK) * 2 + dir) * 1536 + cg_;
            f32x2 pa[NCHUNK];
#pragma unroll
            for (int cc = 0; cc < NCHUNK; ++cc) pa[cc] = ag[(size_t)cc * 2 * 1536];
#pragma unroll
            for (int i = 0; i < NCHUNK; ++i) { const int cc = dir ? NCHUNK - 1 - i : i; const bool use = dir ? (cc > chunk) : (cc < chunk); if (use) hc = pa[cc].x * hc + pa[cc].y; } }
        const int tstart = dir ? SEQ - 1 : 0;
        if (dir == 1) __syncthreads();
#pragma unroll 1
        for (int si = 0; si < 4; ++si) { const int s = dir ? 3 - si : si;
            if (PASS2 && dir == 0) {
#pragma unroll
                for (int i1 = 0; i1 < 4; ++i1)
#pragma unroll
                    for (int i2 = 0; i2 < 4; ++i2) { hf[0][i1][i2] = hf[1][i1][i2]; hf[1][i1][i2] = hf[2][i1][i2]; hf[2][i1][i2] = hf[3][i1][i2]; } }
            f32x4 ar[4], ai[4], ax[4];
#pragma unroll
            for (int rt = 0; rt < 4; ++rt) { ar[rt] = (f32x4){0.f, 0.f, 0.f, 0.f}; ai[rt] = (f32x4){0.f, 0.f, 0.f, 0.f}; ax[rt] = (f32x4){0.f, 0.f, 0.f, 0.f};
#pragma unroll
                for (int ks = 0; ks < 4; ++ks) { const bf16x8 xf = *(const LAS bf16x8*)(AT + (64 * s + 16 * rt + fr) * AT_PITCH + 64 * ks + 16 * fq);
                    ar[rt] = __builtin_amdgcn_mfma_f32_16x16x32_bf16(xf, wrf[ks], ar[rt], 0, 0, 0); ai[rt] = __builtin_amdgcn_mfma_f32_16x16x32_bf16(xf, wif[ks], ai[rt], 0, 0, 0);
                    if (ks == ks0) ax[rt] = __builtin_amdgcn_mfma_f32_16x16x32_bf16(xf, sel, ax[rt], 0, 0, 0); } }
            const int tl0 = 64 * s + 16 * fq;
            float A16 = 1.f, B16 = 0.f;
#pragma unroll
            for (int e = 0; e < 16; ++e) { const int ee = dir ? 15 - e : e; const int rt = ee >> 2, j = ee & 3;
                const float rg = fsig(ar[rt][j] + ba), ig = fsig(ai[rt][j] + bi); const float la = logu * rg; const float av = __expf(la);
                const float mult = (t0 + tl0 + ee == tstart) ? 1.0f : __builtin_amdgcn_sqrtf(fmaxf(1.0f - av * av, 0.f)); const float bv = mult * ig * ax[rt][j];
                ar[rt][j] = av; ai[rt][j] = bv; B16 = av * B16 + bv; A16 = av * A16; }
            const int pos = dir ? 3 - fq : fq;
            float PA = 1.f, PB = 0.f, QA = 1.f, QB = 0.f;
#pragma unroll
            for (int i = 0; i < 4; ++i) { const int k = dir ? 3 - i : i; const float Ak = __shfl(A16, fr + 16 * k), Bk = __shfl(B16, fr + 16 * k);
                if (i < pos) { PB = Ak * PB + Bk; PA = Ak * PA; }
                QB = Ak * QB + Bk; QA = Ak * QA; }
            if (PASS2) {
                float h = PA * hc + PB;
#pragma unroll
                for (int e = 0; e < 16; ++e) { const int ee = dir ? 15 - e : e; const int rt = ee >> 2, j = ee & 3; h = ar[rt][j] * h + ai[rt][j];
                    if (dir == 0) hf[3][rt][j] = h;
                    else { LAS unsigned short* yp = (LAS unsigned short*)(R0 + (tl0 + ee) * AT_PITCH + 2 * c); const float yb = bf2f(*yp);
                        const float u2 = 1.5957691216057308f * (yb + 0.044715f * yb * yb * yb);
                        const float y = (hf[3][rt][j] + h) * yb * fsig(u2);
                        *yp = (unsigned short)(cvt_pk_bf16(y, 0.f) & 0xffffu); } }
                hc = QA * hc + QB;
            } else { TB = QA * TB + QB; TA = QA * TA; }
            if (PASS2 && dir == 1) {
#pragma unroll
                for (int i1 = 0; i1 < 4; ++i1)
#pragma unroll
                    for (int i2 = 0; i2 < 4; ++i2) { hf[3][i1][i2] = hf[2][i1][i2]; hf[2][i1][i2] = hf[1][i1][i2]; hf[1][i1][i2] = hf[0][i1][i2]; } }
        }
        if (!PASS2 && fq == 0) ((f32x2*)(a.ws + WS_AGG))[((size_t)(b * NCHUNK + chunk) * 2 + dir) * 1536 + cg_] = (f32x2){TA, TB};
        };
    dir_body(std::integral_constant<int, 0>{});
    dir_body(std::integral_constant<int, 1>{});
    if (PASS2) {
        __syncthreads();
#pragma unroll
        for (int it = 0; it < 8; ++it) { const int tl = r0 + 32 * it;
            *(u32x4*)((bf16_t*)a.out + (rowbase + t0 + tl) * YP + 512 + n * 128 + 8 * cch) = *(const LAS u32x4*)(R0 + tl * AT_PITCH + 16 * cch); }
    }
}

#define XB_TMO      128
#define XB_XCNT(j)  (256  + 64 * (j))
#define XB_XSUB(j)  (1280 + 64 * (j))
#define XB_XGEN(j)  (2304 + 64 * (j))
#define XB_TOP      3328
#define XB_TOPGEN   3392
#define XCD_BAR_WORDS 3456
#define XB_SPIN_CAP (1u << 18)

__device__ __forceinline__ unsigned xb_ld(unsigned* p)              { return __hip_atomic_load(p, __ATOMIC_RELAXED, __HIP_MEMORY_SCOPE_AGENT); }
__device__ __forceinline__ unsigned xb_add(unsigned* p, unsigned v) { return __hip_atomic_fetch_add(p, v, __ATOMIC_RELAXED, __HIP_MEMORY_SCOPE_AGENT); }
__device__ __forceinline__ unsigned xb_xcc_id() { return (unsigned)__builtin_amdgcn_s_getreg((3 << 11) | 20) & 0xFu; }
#define XB_SPIN(cond, bar) do { unsigned _sp = 0; while (cond) { __builtin_amdgcn_s_sleep(1); \
    if ((++_sp & 255u) == 0u) { if (xb_ld(&(bar)[XB_TMO])) break; if (_sp > XB_SPIN_CAP) { atomicAdd(&(bar)[XB_TMO], 1u); break; } } } } while (0)

struct XcdBarrier {
    unsigned* bar; unsigned x;
    volatile LAS unsigned* st;
};

__device__ __forceinline__ XcdBarrier xcd_barrier_post(unsigned* bar, volatile LAS unsigned* st) {
    XcdBarrier b; b.bar = bar; b.x = xb_xcc_id(); b.st = st;
    if (threadIdx.x == 0) (void)xb_add(&bar[XB_XCNT(b.x)], 1u);
    return b;
}
__device__ __forceinline__ void xcd_barrier_complete(unsigned* bar, unsigned x, unsigned& nloc, unsigned& nx) {
    const unsigned G = gridDim.x * gridDim.y * gridDim.z;
    unsigned sum, cnt, mine, sp = 0u;
    for (;;) {
        sum = 0u; cnt = 0u; mine = 0u;
#pragma unroll
        for (unsigned j = 0; j < 16; ++j) { const unsigned c = xb_ld(&bar[XB_XCNT(j)]); sum += c; cnt += (c > 0u) ? 1u : 0u; mine = (j == x) ? c : mine; }
        if (sum == G) break;
        __builtin_amdgcn_s_sleep(1);
        if ((++sp & 255u) == 0u) { if (xb_ld(&bar[XB_TMO])) break; if (sp > XB_SPIN_CAP) { atomicAdd(&bar[XB_TMO], 1u); break; } }
    }
    nloc = mine > 0u ? mine : 1u; nx = cnt > 0u ? cnt : 1u;
}

__device__ __forceinline__ void xcd_barrier(const XcdBarrier& b) {
    asm volatile("s_waitcnt vmcnt(0)" ::: "memory");
    __syncthreads();
    if (threadIdx.x == 0) {
        unsigned* bar = b.bar;
        __builtin_amdgcn_s_waitcnt(0);
        unsigned nloc = b.st[0], nx = b.st[1];
        if (nloc == 0u) { xcd_barrier_complete(bar, b.x, nloc, nx); b.st[0] = nloc; b.st[1] = nx; }
        const unsigned old = xb_add(&bar[XB_XSUB(b.x)], 1u);
        const unsigned gen = old / nloc;
        if (old + 1u == (gen + 1u) * nloc) {
            __builtin_amdgcn_fence(__ATOMIC_RELEASE, "agent");
            asm volatile("s_waitcnt vmcnt(0)" ::: "memory");
            const unsigned og = xb_add(&bar[XB_TOP], 1u);
            const unsigned tg = og / nx;
            if (og + 1u == (tg + 1u) * nx) xb_add(&bar[XB_TOPGEN], 1u);
            else XB_SPIN(xb_ld(&bar[XB_TOPGEN]) == tg, bar);
            __builtin_amdgcn_fence(__ATOMIC_ACQUIRE, "agent");
            xb_add(&bar[XB_XGEN(b.x)], 1u);
            asm volatile("s_waitcnt vmcnt(0)" ::: "memory");
        } else {
            XB_SPIN(xb_ld(&bar[XB_XGEN(b.x)]) == gen, bar);
            __builtin_amdgcn_fence(__ATOMIC_ACQUIRE, "agent");
            asm volatile("s_waitcnt vmcnt(0)" ::: "memory");
        }
    }
    __syncthreads();
}

__global__ void __launch_bounds__(512, 2) mega_fwd(Args a) {
    extern __shared__ __attribute__((aligned(16))) unsigned char lds_raw[];
    Frame F; F.lds = (LAS unsigned char*)lds_raw; F.tid = threadIdx.x; F.lane = F.tid & 63; F.wave = __builtin_amdgcn_readfirstlane(F.tid >> 6); F.G = gridDim.x; F.bid = blockIdx.x;
    cg::grid_group grid = cg::this_grid();
    unsigned char* ws = a.ws;
    const int lo = a.ph_lo, hi = a.ph_hi;
#ifndef REP_MASK
#define REP_MASK 0
#endif
#define NREP(k) ((((REP_MASK) >> (k)) & 1) ? 2 : 1)
#ifndef SUB_MASK
#define SUB_MASK 7
#endif
#ifndef PH_MASK
#define PH_MASK 0x7ff
#endif
#define IN(k) ((((PH_MASK) >> (k)) & 1) && lo <= (k) && (k) < hi)
#define SEAM(k) do { if (IN(k) && IN((k) + 1)) xcd_barrier(xbar); } while (0)
    const int gw = F.bid * 8 + F.wave, NGW = F.G * 8;
    if (F.tid < 2) ((volatile LAS unsigned*)(F.lds + LDS_XB))[F.tid] = 0u;
    __syncthreads();
    if (F.bid == 0) { for (int i = F.tid; i < XCD_BAR_WORDS; i += 512) __hip_atomic_store((unsigned*)(ws + WS_BAR) + i, 0u, __ATOMIC_RELAXED, __HIP_MEMORY_SCOPE_AGENT); }
    XcdBarrier xbar; xbar.bar = (unsigned*)(ws + WS_BAR); xbar.x = 0; xbar.st = (volatile LAS unsigned*)(F.lds + LDS_XB);

    if (IN(0)) for (int rep = 0; rep < NREP(0); ++rep) { phase0(F, a); if (rep + 1 < NREP(0)) __syncthreads(); }
    if (IN(0) && IN(1)) { grid.sync(); xbar = xcd_barrier_post((unsigned*)(ws + WS_BAR), (volatile LAS unsigned*)(F.lds + LDS_XB)); }
    if (IN(1)) {
        { pg8::Gemm g{(const bf16_t*)(ws + WS_H), (const bf16_t*)(ws + WS_WIN), M, NIN, D, D, D}; pg8::StaticOrder S; S.init(M, NIN, F.G, F.bid, NREP(1));
          pg8::EpiBf16<0> E{(bf16_t*)(ws + WS_PROJ), NIN, nullptr}; pg8::gemm_phase(F.lds, g, S, E); }
        { pg8::Gemm g{(const bf16_t*)(ws + WS_MEMN), (const bf16_t*)(ws + WS_WMKV), BATCH * NMEM, 2048, D, D, D}; pg8::StaticOrder S; S.init(BATCH * NMEM, 2048, 32, F.bid >= F.G - 32 ? F.bid - (F.G - 32) : -1);
          pg8::EpiBf16<0> E{(bf16_t*)(ws + WS_KV), 2048, nullptr}; pg8::gemm_phase(F.lds, g, S, E); }
    }
    SEAM(1);
    if (IN(2)) {
        constexpr int N_L = BATCH * NCHUNK * 12, N_A = BATCH * 12 * 32, N_C = BATCH * 4 * 32;
        if (F.bid & 1) {
            for (int it = F.bid; it < N_L; it += F.G) lru_item<false>(F, a, it);
            for (int it = F.bid; it < N_A; it += F.G) attnA_item(F, a, it);
            for (int it = F.bid; it < N_C; it += F.G) attnC_item(F, a, it);
        } else {
            for (int it = F.bid; it < N_A; it += F.G) attnA_item(F, a, it);
            for (int it = F.bid; it < N_C; it += F.G) attnC_item(F, a, it);
            for (int it = F.bid; it < N_L; it += F.G) lru_item<false>(F, a, it);
        }
    }
    SEAM(2);
    if (IN(3)) {
        constexpr int N_L2 = BATCH * NCHUNK * 12;
        const bool gemm_first = ((F.bid >> 3) & 1) == 0;
#define P3_GEMM() do { __syncthreads(); pg8::Gemm g{(const bf16_t*)(ws + WS_H), (const bf16_t*)(ws + WS_WGATE), M, NG, D, D, D}; pg8::StaticOrder S; S.init(M, NG, F.G, F.bid); \
            pg8::EpiGate8 E{ws + WS_PROJ, a.b_gate}; pg8::gemm_phase(F.lds, g, S, E); } while (0)
#define P3_LRU() do { for (int it = F.bid; it < N_L2; it += F.G) lru_item<true>(F, a, it); for (int m = gw; m < M; m += NGW) combine_row(a, (size_t)m, F.lane); } while (0)
        if (gemm_first) { P3_GEMM(); P3_LRU(); } else { P3_LRU(); P3_GEMM(); }
#undef P3_GEMM
#undef P3_LRU
    }
    SEAM(3);
    if (IN(5)) {
        pg8::Gemm g{(const bf16_t*)a.out, (const bf16_t*)(ws + WS_WO), M, D, YP, YP, YP}; pg8::StaticOrder S; S.init(M, D, F.G, F.bid, NREP(5));
        pg8::EpiMix E{(bf16_t*)(ws + WS_H), ws + WS_PROJ}; pg8::gemm_phase(F.lds, g, S, E);
    }
    SEAM(5);
    if (IN(6)) {
        pg8::Gemm g{(const bf16_t*)(ws + WS_H), (const bf16_t*)(ws + WS_WOUT), M, D, D, D, D}; pg8::StaticOrder S; S.init(M, D, F.G, F.bid, NREP(6));
        pg8::EpiBf16<0> E{(bf16_t*)(ws + WS_H2), D, nullptr}; pg8::gemm_phase(F.lds, g, S, E);
    }
    SEAM(6);
    if (IN(7)) { for (int m = gw; m < M; m += NGW) rms_row_add_bf16(a.x + (size_t)m * D, (const bf16_t*)(ws + WS_H2) + (size_t)m * D, a.norm_mlp, (bf16_t*)(ws + WS_H) + (size_t)m * D, F.lane); }
    SEAM(7);
    if (IN(8)) {
        pg8::Gemm g{(const bf16_t*)(ws + WS_H), (const bf16_t*)(ws + WS_WUP), M, DFF, D, D, D}; pg8::StaticOrder S; S.init(M, DFF, F.G, F.bid, NREP(8));
        pg8::EpiBf16<2> E{(bf16_t*)(ws + WS_PROJ), DFF, nullptr}; pg8::gemm_phase(F.lds, g, S, E);
    }
    SEAM(8);
    if (IN(9)) {
        pg8::Gemm g{(const bf16_t*)(ws + WS_PROJ), (const bf16_t*)(ws + WS_WDN), M, D, DFF, DFF, DFF}; pg8::StaticOrder S; S.init(M, D, F.G, F.bid, NREP(9), 4);
        pg8::EpiBf16<0> E{(bf16_t*)(ws + WS_H), D, nullptr}; pg8::gemm_phase(F.lds, g, S, E);
    }
    SEAM(9);
    if (IN(10)) { for (int m = gw; m < M; m += NGW) rms_row_final(a.x + (size_t)m * D, (const bf16_t*)(ws + WS_H2) + (size_t)m * D, (const bf16_t*)(ws + WS_H) + (size_t)m * D, a.norm_final, a.out + (size_t)m * D, F.lane); }
#undef IN
#undef SEAM
}

#ifndef MK_SPLIT
#define MK_SPLIT 0
#endif
extern "C" void kernel_launch(void* const* d_in, const int* in_sizes, int n_in, void* d_out, int out_size, void* d_ws, size_t ws_size, hipStream_t stream) {
    static int grid = 0;
    if (grid == 0) {
        if (n_in != 24 || in_sizes[0] != M * D || out_size != M * D || ws_size < WS_END) { fprintf(stderr, "kernel_launch: unexpected shapes (n_in %d, in0 %d, out %d, ws %zu); nothing launched\n", n_in, n_in > 0 ? in_sizes[0] : -1, out_size, ws_size); grid = -1; return; }
        int dev = 0, cus = 0, per_cu = 0;
        (void)hipGetDevice(&dev); (void)hipDeviceGetAttribute(&cus, hipDeviceAttributeMultiprocessorCount, dev);
        if (hipFuncSetAttribute((const void*)mega_fwd, hipFuncAttributeMaxDynamicSharedMemorySize, LDS_BYTES) != hipSuccess) { fprintf(stderr, "kernel_launch: hipFuncSetAttribute failed\n"); grid = -1; return; }
        if (hipOccupancyMaxActiveBlocksPerMultiprocessor(&per_cu, (const void*)mega_fwd, 512, LDS_BYTES) != hipSuccess || per_cu < 1) { fprintf(stderr, "kernel_launch: occupancy query says %d blocks per CU\n", per_cu); (void)hipGetLastError(); }
        grid = cus > 0 ? cus : 256;
    }
    if (grid < 0) return;
    Args a{};
    const float** p = (const float**)&a;
    for (int i = 0; i < 24; ++i) p[i] = (const float*)d_in[i];
    a.out = (float*)d_out; a.ws = (unsigned char*)d_ws;
#if MK_SPLIT
    for (int ph = 0; ph < 11; ++ph) { a.ph_lo = ph; a.ph_hi = ph + 1; hipLaunchKernelGGL(mega_fwd, dim3(grid), dim3(512), LDS_BYTES, stream, a); }
#else
    a.ph_lo = 0; a.ph_hi = 11;
    void* args[] = {&a};
    hipError_t e = hipLaunchCooperativeKernel((const void*)mega_fwd, dim3(grid), dim3(512), args, LDS_BYTES, stream);
    if (e != hipSuccess) fprintf(stderr, "kernel_launch: cooperative launch failed: %s (grid %d)\n", hipGetErrorString(e), grid);
#endif
}
```

```cpp
#include <hip/hip_runtime.h>
#include <hip/hip_cooperative_groups.h>
#include <cstdio>
#include <cstdint>
#include <type_traits>
namespace cg = cooperative_groups;

#define LAS __attribute__((address_space(3)))
typedef unsigned short bf16_t;
typedef short bf16x8 __attribute__((ext_vector_type(8)));
typedef short s16x4 __attribute__((ext_vector_type(4)));
typedef float f32x4 __attribute__((ext_vector_type(4)));
typedef float f32x2 __attribute__((ext_vector_type(2)));
typedef unsigned u32x4 __attribute__((ext_vector_type(4)));
typedef unsigned u32x2 __attribute__((ext_vector_type(2)));

constexpr int D = 2048, BATCH = 4, SEQ = 4096, M = BATCH * SEQ;
constexpr int NIN = 8704, NG = 6144, DFF = 8192, NMEM = 256;
constexpr int C_Q = 0, C_K = 1536, C_V = 3072, C_XB = 4608, C_YB = 6144, C_QC = 7680;
constexpr int YP = 3072;
constexpr float EPS = 1e-6f;
constexpr int NCHUNK = 16, CHUNK = 256;

constexpr size_t MiB = 1u << 20;
constexpr size_t WS_TAB = 0;
constexpr size_t WS_BAR = 65536;
constexpr size_t WS_LSE = 1 * MiB;
constexpr size_t WS_AGG = 2 * MiB;
constexpr size_t WS_SSQ = 3 * MiB + 768 * 1024;
constexpr size_t WS_H2 = 14 * MiB;
constexpr size_t WS_WLRU = 4 * MiB;
constexpr size_t WS_MEMN = 6 * MiB;
constexpr size_t WS_KV = 10 * MiB;
constexpr size_t WS_WIN = 14 * MiB;
constexpr size_t WS_WGATE = 48 * MiB;
constexpr size_t WS_WMKV = 72 * MiB;
constexpr size_t WS_WO = 80 * MiB;
constexpr size_t WS_WOUT = 92 * MiB;
constexpr size_t WS_WUP = 100 * MiB;
constexpr size_t WS_WDN = 132 * MiB;
constexpr size_t WS_H = 164 * MiB;
constexpr size_t WS_PROJ = 228 * MiB;
constexpr size_t WS_END = 500 * MiB;
constexpr size_t DO_O12 = 96 * MiB;

constexpr int LDS_BYTES = 147456;
constexpr int LDS_XB = 147456 - 64;

__device__ __forceinline__ unsigned cvt_pk_bf16(float lo, float hi) { unsigned r; asm volatile("v_cvt_pk_bf16_f32 %0, %1, %2" : "=v"(r) : "v"(lo), "v"(hi)); return r; }
__device__ __forceinline__ float bf2f(unsigned short b) { return __uint_as_float(((unsigned)b) << 16); }
__device__ __forceinline__ float bflo(unsigned w) { return __uint_as_float(w << 16); }
__device__ __forceinline__ float bfhi(unsigned w) { return __uint_as_float(w & 0xffff0000u); }
__device__ __forceinline__ float wave_sum(float v) {
#pragma unroll
    for (int o = 1; o < 64; o <<= 1) v += __shfl_xor(v, o);
    return v;
}
__device__ __forceinline__ float sigmoidf_(float x) { return 1.0f / (1.0f + __expf(-x)); }
__device__ __forceinline__ float gelu_tanh(float x) { const float u = 0.7978845608028654f * (x + 0.044715f * x * x * x); return 0.5f * x * (1.0f + tanhf(u)); }

namespace pg8 {
constexpr int BM = 256, BK = 64, HALF = 128, HTB = HALF * BK * 2, STAGE_BYTES = 8 * HTB, NXCD = 8, WGM = 8;
__host__ __device__ __forceinline__ int lds_byte(int r, int c) { const int st = (r >> 4) * 2 + (c >> 5), rr = r & 15, cc = c & 31, ob = rr * 64 + cc * 2; return st * 1024 + (ob ^ (((ob >> 9) & 1) << 5)); }
__host__ __device__ __forceinline__ void stage_rc(int b, int& R, int& C) { const int st = b / 1024, sb = b % 1024, swz = sb ^ (((sb >> 9) & 1) << 5); R = (st >> 1) * 16 + swz / 64; C = (st & 1) * 32 + (swz % 64) / 2; }
__host__ __device__ __forceinline__ int perm32(int rho) { const int n = rho >> 4, i = rho & 15; return 8 * (i >> 2) + 4 * n + (i & 3); }

struct Unit { int pm, pn; };
struct Gemm { const bf16_t* A; const bf16_t* Bt; int M, N, K, lda, ldb; };

struct StaticOrder {
    int nM, nN, nwg, G, c, rep, wgm;
    __host__ __device__ void init(int M_, int N_, int G_, int c_, int rep_ = 1, int wgm_ = WGM) { nM = M_ / BM; nN = N_ / BM; nwg = nM * nN; G = G_; c = c_; rep = rep_; wgm = wgm_; }
    __host__ __device__ bool next(int i, Unit& u) const {
        long L = (long)i * G + c; if (c < 0 || L >= (long)nwg * rep) return false;
        if (L >= nwg) L -= nwg;
        int wgid = (int)L; { const int q = nwg / NXCD, r = nwg % NXCD, xcd = wgid % NXCD, off = wgid / NXCD; wgid = (xcd < r ? xcd * (q + 1) : r * (q + 1) + (xcd - r) * q) + off; }
        const int nig = wgm * nN, gid = wgid / nig, fm = gid * wgm, gsz = (nM - fm) < wgm ? (nM - fm) : wgm;
        u.pm = fm + ((wgid % nig) % gsz); u.pn = (wgid % nig) / gsz; return true;
    }
};

template <int ACT  > struct EpiBf16 {
    static constexpr bool PERM = true, MID = false;
    bf16_t* O; int ldc; const float* bias;
    __device__ __forceinline__ void operator()(const f32x4 (&acc)[2][2][4][2], const Unit& u, int wr, int wc, int fr, int fq) const {
        const int row0 = u.pm * BM + wr * 64 + fr; const int col0 = u.pn * BM + wc * 32 + 8 * fq;
        f32x4 bv[2][2];
#pragma unroll
        for (int bj = 0; bj < 2; ++bj)
#pragma unroll
            for (int n = 0; n < 2; ++n) bv[bj][n] = (ACT == 1) ? *(const f32x4*)(bias + col0 + bj * HALF + 4 * n) : (f32x4){0.f, 0.f, 0.f, 0.f};
#pragma unroll
        for (int ai = 0; ai < 2; ++ai)
#pragma unroll
            for (int m = 0; m < 4; ++m) { bf16_t* rowp = O + (size_t)(row0 + ai * HALF + m * 16) * ldc + col0;
#pragma unroll
                for (int bj = 0; bj < 2; ++bj) { f32x4 v0 = acc[ai][bj][m][0], v1 = acc[ai][bj][m][1];
                    if (ACT == 1) { v0 += bv[bj][0]; v1 += bv[bj][1];
#pragma unroll
                        for (int j = 0; j < 4; ++j) { v0[j] = sigmoidf_(v0[j]); v1[j] = sigmoidf_(v1[j]); } }
                    if (ACT == 2) {
#pragma unroll
                        for (int j = 0; j < 4; ++j) { const float a = fmaxf(v0[j], 0.f), b = fmaxf(v1[j], 0.f); v0[j] = a * a; v1[j] = b * b; } }
                    u32x4 w; w.x = cvt_pk_bf16(v0[0], v0[1]); w.y = cvt_pk_bf16(v0[2], v0[3]); w.z = cvt_pk_bf16(v1[0], v1[1]); w.w = cvt_pk_bf16(v1[2], v1[3]);
                    *(u32x4*)(rowp + bj * HALF) = w; } }
    }
};
struct EpiResF32 {
    static constexpr bool PERM = false, MID = false;
    float* out; const float* res; int ldc;
    __device__ __forceinline__ void operator()(const f32x4 (&acc)[2][2][4][2], const Unit& u, int wr, int wc, int fr, int fq) const {
        const int row0 = u.pm * BM + wr * 64 + fr, col0 = u.pn * BM + wc * 32 + 4 * fq;
#pragma unroll
        for (int ai = 0; ai < 2; ++ai)
#pragma unroll
            for (int m = 0; m < 4; ++m) { const size_t off = (size_t)(row0 + ai * HALF + m * 16) * ldc + col0;
#pragma unroll
                for (int bj = 0; bj < 2; ++bj)
#pragma unroll
                    for (int n = 0; n < 2; ++n) { const f32x4 r = *(const f32x4*)(res + off + bj * HALF + n * 16); *(f32x4*)(out + off + bj * HALF + n * 16) = acc[ai][bj][m][n] + r; } }
    }
};
struct EpiResNorm {
    static constexpr bool PERM = false, MID = false;
    float* out; const float* res; const float* gain; bf16_t* xg; float* ssq;
    __device__ __forceinline__ void operator()(const f32x4 (&acc)[2][2][4][2], const Unit& u, int wr, int wc, int fr, int fq) const {
        const int row0 = u.pm * BM + wr * 64 + fr, col0 = u.pn * BM + wc * 32 + 4 * fq;
        f32x4 gv[2][2];
#pragma unroll
        for (int bj = 0; bj < 2; ++bj)
#pragma unroll
            for (int n = 0; n < 2; ++n) gv[bj][n] = *(const f32x4*)(gain + col0 + bj * HALF + n * 16);
#pragma unroll
        for (int ai = 0; ai < 2; ++ai)
#pragma unroll
            for (int m = 0; m < 4; ++m) { const int row = row0 + ai * HALF + m * 16; const size_t off = (size_t)row * D + col0; float sq = 0.f;
#pragma unroll
                for (int bj = 0; bj < 2; ++bj)
#pragma unroll
                    for (int n = 0; n < 2; ++n) { const f32x4 r = *(const f32x4*)(res + off + bj * HALF + n * 16); const f32x4 v = acc[ai][bj][m][n] + r;
                        *(f32x4*)(out + off + bj * HALF + n * 16) = v; sq += (v[0] * v[0] + v[1] * v[1]) + (v[2] * v[2] + v[3] * v[3]);
                        const f32x4 g = gv[bj][n]; u32x2 w; w.x = cvt_pk_bf16(v[0] * g[0], v[1] * g[1]); w.y = cvt_pk_bf16(v[2] * g[2], v[3] * g[3]);
                        *(u32x2*)(xg + off + bj * HALF + n * 16) = w; }
                sq += __shfl_xor(sq, 16); sq += __shfl_xor(sq, 32);
                if (fq == 0) atomicAdd(ssq + row, sq); }
    }
};
struct EpiRelu2Norm {
    static constexpr bool PERM = true, MID = false;
    bf16_t* O; int ldc; const float* ssq;
    __device__ __forceinline__ void operator()(const f32x4 (&acc)[2][2][4][2], const Unit& u, int wr, int wc, int fr, int fq) const {
        const int row0 = u.pm * BM + wr * 64 + fr; const int col0 = u.pn * BM + wc * 32 + 8 * fq;
#pragma unroll
        for (int ai = 0; ai < 2; ++ai)
#pragma unroll
            for (int m = 0; m < 4; ++m) { const int row = row0 + ai * HALF + m * 16; bf16_t* rowp = O + (size_t)row * ldc + col0;
                const float r2 = __builtin_amdgcn_rcpf(ssq[row] * (1.0f / D) + EPS);
#pragma unroll
                for (int bj = 0; bj < 2; ++bj) { f32x4 v0 = acc[ai][bj][m][0], v1 = acc[ai][bj][m][1];
#pragma unroll
                    for (int j = 0; j < 4; ++j) { const float a = fmaxf(v0[j], 0.f), b = fmaxf(v1[j], 0.f); v0[j] = a * a * r2; v1[j] = b * b * r2; }
                    u32x4 w; w.x = cvt_pk_bf16(v0[0], v0[1]); w.y = cvt_pk_bf16(v0[2], v0[3]); w.z = cvt_pk_bf16(v1[0], v1[1]); w.w = cvt_pk_bf16(v1[2], v1[3]);
                    *(u32x4*)(rowp + bj * HALF) = w; } }
    }
};
constexpr int GP8 = 17408;
__device__ __forceinline__ float ub0(unsigned w) { return (float)(w & 0xffu); }
__device__ __forceinline__ float ub1(unsigned w) { return (float)((w >> 8) & 0xffu); }
__device__ __forceinline__ float ub2(unsigned w) { return (float)((w >> 16) & 0xffu); }
__device__ __forceinline__ float ub3(unsigned w) { return (float)(w >> 24); }
struct EpiGate8 {
    static constexpr bool PERM = true, MID = false;
    unsigned char* O; const float* bias;
    __device__ __forceinline__ void operator()(const f32x4 (&acc)[2][2][4][2], const Unit& u, int wr, int wc, int fr, int fq) const {
        const int row0 = u.pm * BM + wr * 64 + fr; const int col0 = u.pn * BM + wc * 32 + 8 * fq;
        f32x4 bv[2][2];
#pragma unroll
        for (int bj = 0; bj < 2; ++bj)
#pragma unroll
            for (int n = 0; n < 2; ++n) bv[bj][n] = *(const f32x4*)(bias + col0 + bj * HALF + 4 * n);
#pragma unroll
        for (int ai = 0; ai < 2; ++ai)
#pragma unroll
            for (int m = 0; m < 4; ++m) { unsigned char* rowp = O + (size_t)(row0 + ai * HALF + m * 16) * GP8 + col0;
#pragma unroll
                for (int bj = 0; bj < 2; ++bj) { const f32x4 v0 = acc[ai][bj][m][0] + bv[bj][0], v1 = acc[ai][bj][m][1] + bv[bj][1];
                    unsigned q[8];
#pragma unroll
                    for (int j = 0; j < 4; ++j) { q[j] = (unsigned)fmaxf(__builtin_rintf(sigmoidf_(v0[j]) * 255.f), 1.f); q[4 + j] = (unsigned)fmaxf(__builtin_rintf(sigmoidf_(v1[j]) * 255.f), 1.f); }
                    u32x2 w; w.x = q[0] | (q[1] << 8) | (q[2] << 16) | (q[3] << 24); w.y = q[4] | (q[5] << 8) | (q[6] << 16) | (q[7] << 24);
                    *(u32x2*)(rowp + bj * HALF) = w; } }
    }
};
struct EpiMix {
    static constexpr bool PERM = true, MID = true;
    bf16_t* O; const unsigned char* gates;
    __device__ __forceinline__ bool is_mid(int t) const { return t == 8 || t == 32; }
    __device__ __forceinline__ void mid(f32x4 (&acc)[2][2][4][2], const Unit& u, int wr, int wc, int fr, int fq, int t) const {
        const int offx = (t == 8) ? 0 : 2048;
        const unsigned char* gp0 = gates + (size_t)(u.pm * BM + wr * 64 + fr) * GP8 + u.pn * BM + wc * 32 + 8 * fq + offx;
#pragma unroll
        for (int ai = 0; ai < 2; ++ai) {
            u32x2 gx[4][2], gy[4][2];
#pragma unroll
            for (int m = 0; m < 4; ++m)
#pragma unroll
                for (int bj = 0; bj < 2; ++bj) { const unsigned char* gp = gp0 + (size_t)(ai * HALF + m * 16) * GP8 + bj * HALF; gx[m][bj] = *(const u32x2*)gp; gy[m][bj] = *(const u32x2*)(gp + 2048); }
#pragma unroll
            for (int m = 0; m < 4; ++m)
#pragma unroll
                for (int bj = 0; bj < 2; ++bj) { const u32x2 x = gx[m][bj], y = gy[m][bj];
                    f32x4 r0, r1;
                    r0[0] = __fdividef(ub0(x.x), ub0(y.x)); r0[1] = __fdividef(ub1(x.x), ub1(y.x)); r0[2] = __fdividef(ub2(x.x), ub2(y.x)); r0[3] = __fdividef(ub3(x.x), ub3(y.x));
                    r1[0] = __fdividef(ub0(x.y), ub0(y.y)); r1[1] = __fdividef(ub1(x.y), ub1(y.y)); r1[2] = __fdividef(ub2(x.y), ub2(y.y)); r1[3] = __fdividef(ub3(x.y), ub3(y.y));
                    acc[ai][bj][m][0] *= r0; acc[ai][bj][m][1] *= r1; }
            asm volatile("" ::: "memory"); }
    }
    __device__ __forceinline__ void operator()(const f32x4 (&acc)[2][2][4][2], const Unit& u, int wr, int wc, int fr, int fq) const {
        const int row0 = u.pm * BM + wr * 64 + fr; const int col0 = u.pn * BM + wc * 32 + 8 * fq; const float k = 1.0f / 255.0f;
#pragma unroll
        for (int ai = 0; ai < 2; ++ai)
#pragma unroll
            for (int m = 0; m < 4; ++m) { const size_t row = (size_t)(row0 + ai * HALF + m * 16);
#pragma unroll
                for (int bj = 0; bj < 2; ++bj) { const u32x2 g = *(const u32x2*)(gates + row * GP8 + 4096 + col0 + bj * HALF);
                    const f32x4 v0 = acc[ai][bj][m][0] * k, v1 = acc[ai][bj][m][1] * k;
                    u32x4 w; w.x = cvt_pk_bf16(v0[0] * ub0(g.x), v0[1] * ub1(g.x)); w.y = cvt_pk_bf16(v0[2] * ub2(g.x), v0[3] * ub3(g.x));
                    w.z = cvt_pk_bf16(v1[0] * ub0(g.y), v1[1] * ub1(g.y)); w.w = cvt_pk_bf16(v1[2] * ub2(g.y), v1[3] * ub3(g.y));
                    *(u32x4*)(O + row * D + col0 + bj * HALF) = w; } }
    }
};

template <class Epi, class Sched, bool ALIGN_EPI = true>
__device__ __forceinline__ void gemm_phase(LAS unsigned char* lds, const Gemm g, const Sched& S, const Epi& E) {
    const int tid = threadIdx.x, wid = __builtin_amdgcn_readfirstlane(tid >> 6), lane = tid & 63, wr = wid >> 2, wc = wid & 3, fr = lane & 15, fq = lane >> 4;
    const int K = g.K, nt = K / BK;
    unsigned voffA[2], voffB[2];
#pragma unroll
    for (int i = 0; i < 2; ++i) { int R, C; stage_rc(tid * 16 + i * 8192, R, C); const int Rb = Epi::PERM ? ((R & ~31) + perm32(R & 31)) : R;
        voffA[i] = (unsigned)(R * g.lda + C) * 2u; voffB[i] = (unsigned)(Rb * g.ldb + C) * 2u; }
    const size_t kstep = (size_t)(BK * 2);
    const size_t hstepA = (size_t)HALF * g.lda * 2, hstepB = (size_t)HALF * g.ldb * 2;
    const size_t tstepA = 2 * hstepA, tstepB = 2 * hstepB;
    const unsigned ldsw = (unsigned)wid * 1024u;
    const int aoff = lds_byte(wr * 64 + fr, fq * 8), boff = lds_byte(wc * 32 + fr, fq * 8);
#define PG8_SA(b, h) (((b) * 2 + (h)) * HTB)
#define PG8_SB(b, h) ((4 + (b) * 2 + (h)) * HTB)
#define PG8_STAGE(bufoff, gbase, voff) do { _Pragma("unroll") for (int _i = 0; _i < 2; ++_i) \
        __builtin_amdgcn_global_load_lds((const unsigned*)((const char*)(gbase) + (voff)[_i]), (LAS unsigned*)(lds + (bufoff) + ldsw + _i * 8192), 16, 0, 0); } while (0)
#define PG8_LDA(dst, b, h) do { _Pragma("unroll") for (int m = 0; m < 4; ++m) _Pragma("unroll") for (int k = 0; k < 2; ++k) dst[m][k] = *(const LAS bf16x8*)(lds + PG8_SA(b, h) + aoff + m * 2048 + k * 1024); } while (0)
#define PG8_LDB(dst, b, h) do { _Pragma("unroll") for (int n = 0; n < 2; ++n) _Pragma("unroll") for (int k = 0; k < 2; ++k) dst[n][k] = *(const LAS bf16x8*)(lds + PG8_SB(b, h) + boff + n * 2048 + k * 1024); } while (0)
#define PG8_MMA(ai, bj, At, Bt) do { __builtin_amdgcn_s_setprio(1); _Pragma("unroll") for (int m = 0; m < 4; ++m) _Pragma("unroll") for (int n = 0; n < 2; ++n) _Pragma("unroll") for (int k = 0; k < 2; ++k) \
        acc[ai][bj][m][n] = __builtin_amdgcn_mfma_f32_16x16x32_bf16(Bt[n][k], At[m][k], acc[ai][bj][m][n], 0, 0, 0); __builtin_amdgcn_s_setprio(0); } while (0)
#define PG8_WAIT_V(n) asm volatile("s_waitcnt vmcnt(" #n ")" ::: "memory")
#define PG8_WAIT_L(n) asm volatile("s_waitcnt lgkmcnt(" #n ")" ::: "memory")
#define PG8_BAR __builtin_amdgcn_s_barrier()
#define PG8_SCHED __builtin_amdgcn_sched_barrier(0)
    Unit cur, nxt; int ui = 0;
    if (!S.next(0, cur)) return;
    f32x4 acc[2][2][4][2];
#pragma unroll
    for (int a = 0; a < 2; ++a)
#pragma unroll
        for (int b = 0; b < 2; ++b)
#pragma unroll
            for (int m = 0; m < 4; ++m)
#pragma unroll
                for (int n = 0; n < 2; ++n) acc[a][b][m][n] = (f32x4){0.f, 0.f, 0.f, 0.f};
    bf16x8 At[4][2], B0[2][2], B1[2][2];
    const char* cA = (const char*)g.A + (size_t)cur.pm * tstepA; const char* cB = (const char*)g.Bt + (size_t)cur.pn * tstepB;
    PG8_STAGE(PG8_SB(0, 0), cB, voffB); PG8_STAGE(PG8_SB(0, 1), cB + hstepB, voffB); PG8_STAGE(PG8_SA(0, 0), cA, voffA); PG8_STAGE(PG8_SA(0, 1), cA + hstepA, voffA);
    if (wr == 1) PG8_BAR;
    PG8_WAIT_V(2); PG8_BAR;
    PG8_STAGE(PG8_SB(1, 0), cB + kstep, voffB); PG8_STAGE(PG8_SA(1, 0), cA + kstep, voffA); PG8_STAGE(PG8_SB(1, 1), cB + hstepB + kstep, voffB);
    PG8_WAIT_V(6); PG8_BAR;
    for (;;) {
        const bool has_next = S.next(ui + 1, nxt);
        const char* nA = has_next ? (const char*)g.A + (size_t)nxt.pm * tstepA : cA; const char* nB = has_next ? (const char*)g.Bt + (size_t)nxt.pn * tstepB : cB;
        for (int t = 0; t < nt; t += 2) {
            const bool last = (t == nt - 2);
            const char* a1 = cA + (size_t)(t + 1) * kstep;
            const char* a2 = last ? nA : cA + (size_t)(t + 2) * kstep; const char* b2 = last ? nB : cB + (size_t)(t + 2) * kstep;
            const char* a3 = a2 + kstep; const char* b3 = b2 + kstep;
            PG8_LDB(B0, 0, 0); PG8_LDB(B1, 0, 1); PG8_SCHED; PG8_LDA(At, 0, 0); PG8_STAGE(PG8_SA(1, 1), a1 + hstepA, voffA);
            PG8_WAIT_V(8); PG8_WAIT_L(0); PG8_BAR; PG8_MMA(0, 0, At, B0); PG8_MMA(0, 1, At, B1); PG8_BAR; PG8_SCHED;
            PG8_LDA(At, 0, 1); PG8_STAGE(PG8_SB(0, 0), b2, voffB); PG8_STAGE(PG8_SB(0, 1), b2 + hstepB, voffB); PG8_STAGE(PG8_SA(0, 0), a2, voffA);
            PG8_WAIT_V(8); PG8_WAIT_L(0); PG8_BAR; PG8_MMA(1, 0, At, B0); PG8_MMA(1, 1, At, B1); PG8_BAR; PG8_SCHED;
            PG8_LDB(B0, 1, 0); PG8_LDB(B1, 1, 1); PG8_SCHED; PG8_LDA(At, 1, 0); PG8_STAGE(PG8_SA(0, 1), a2 + hstepA, voffA);
            PG8_WAIT_V(8); PG8_WAIT_L(0); PG8_BAR; PG8_MMA(0, 0, At, B0); PG8_MMA(0, 1, At, B1); PG8_BAR; PG8_SCHED;
            PG8_LDA(At, 1, 1); PG8_STAGE(PG8_SB(1, 0), b3, voffB); PG8_STAGE(PG8_SB(1, 1), b3 + hstepB, voffB); PG8_STAGE(PG8_SA(1, 0), a3, voffA);
            PG8_WAIT_V(8); PG8_WAIT_L(0); PG8_BAR; PG8_MMA(1, 0, At, B0); PG8_MMA(1, 1, At, B1); PG8_BAR; PG8_SCHED;
            if constexpr (Epi::MID) { if (E.is_mid(t + 2)) { E.mid(acc, cur, wr, wc, fr, fq, t + 2); PG8_SCHED; } }
        }
        if constexpr (ALIGN_EPI) { if (wr == 0) PG8_BAR; }
        E(acc, cur, wr, wc, fr, fq);
        if (!has_next) break;
#pragma unroll
        for (int a = 0; a < 2; ++a)
#pragma unroll
            for (int b = 0; b < 2; ++b)
#pragma unroll
                for (int m = 0; m < 4; ++m)
#pragma unroll
                    for (int n = 0; n < 2; ++n) acc[a][b][m][n] = (f32x4){0.f, 0.f, 0.f, 0.f};
        cur = nxt; cA = nA; cB = nB; ++ui;
        if constexpr (ALIGN_EPI) { if (wr == 1) PG8_BAR; }
    }
    PG8_WAIT_V(0);
    if constexpr (!ALIGN_EPI) { if (wr == 0) PG8_BAR; }
    PG8_BAR;
#undef PG8_SA
#undef PG8_SB
#undef PG8_STAGE
#undef PG8_LDA
#undef PG8_LDB
#undef PG8_MMA
#undef PG8_WAIT_V
#undef PG8_WAIT_L
#undef PG8_BAR
#undef PG8_SCHED
}
}

struct Args {
    const float *x, *mem, *rel_bias, *norm_mix, *norm_mem, *norm_mlp, *norm_final, *w_in, *w_gate, *b_gate, *conv_w, *conv_b,
                *lru_wa, *lru_ba, *lru_wi, *lru_bi, *lru_lambda, *w_mem_kv, *w_o_attn, *w_o_lru, *w_o_mem, *w_out, *w_up, *w_down;
    float* out; unsigned char* ws; int ph_lo, ph_hi;
};

struct Frame { LAS unsigned char* lds; int tid, lane, wave, G, bid; };

__device__ __forceinline__ void p0_transpose_item(const float* W, int N, bf16_t* WT, int ldt, int coff, LAS float* scr, int item, int lane) {
    const int nblk = N / 32, kb = item / nblk, nb = item % nblk, k0 = 64 * kb, n0 = 32 * nb;
    { f32x4 v[8];
#pragma unroll
      for (int i = 0; i < 8; ++i) v[i] = *(const f32x4*)(W + (size_t)(k0 + 8 * i + (lane >> 3)) * N + n0 + 4 * (lane & 7));
#pragma unroll
      for (int i = 0; i < 8; ++i) { LAS float* d = scr + (8 * i + (lane >> 3)) * 33 + 4 * (lane & 7); d[0] = v[i].x; d[1] = v[i].y; d[2] = v[i].z; d[3] = v[i].w; } }
    asm volatile("s_waitcnt lgkmcnt(0)" ::: "memory");
    const int c = lane & 7;
#pragma unroll
    for (int j = 0; j < 4; ++j) { const int n = (lane >> 3) + 8 * j; const LAS float* s = scr + (8 * c) * 33 + n;
        u32x4 o; o.x = cvt_pk_bf16(s[0 * 33], s[1 * 33]); o.y = cvt_pk_bf16(s[2 * 33], s[3 * 33]); o.z = cvt_pk_bf16(s[4 * 33], s[5 * 33]); o.w = cvt_pk_bf16(s[6 * 33], s[7 * 33]);
        *(u32x4*)(WT + (size_t)(n0 + n) * ldt + coff + k0 + 8 * c) = o; }
    asm volatile("s_waitcnt lgkmcnt(0)" ::: "memory");
}
__device__ __forceinline__ void rms_row_bf16(const float* xrow, const float* gain, bf16_t* orow, int lane) {
    const f32x4* xr = (const f32x4*)xrow + lane; const f32x4* gr = (const f32x4*)gain + lane;
    f32x4 v[8]; float s = 0.f;
#pragma unroll
    for (int j = 0; j < 8; ++j) { v[j] = xr[64 * j]; s += (v[j].x * v[j].x + v[j].y * v[j].y) + (v[j].z * v[j].z + v[j].w * v[j].w); }
    const float rs = rsqrtf(wave_sum(s) * (1.f / D) + EPS);
    u32x2* o8 = (u32x2*)orow + lane;
#pragma unroll
    for (int j = 0; j < 8; ++j) { const f32x4 g = gr[64 * j]; u32x2 w; w.x = cvt_pk_bf16(v[j].x * rs * g.x, v[j].y * rs * g.y); w.y = cvt_pk_bf16(v[j].z * rs * g.z, v[j].w * rs * g.w); o8[64 * j] = w; }
}
__device__ __forceinline__ void rms_row_f32(float* xrow, const float* gain, int lane) {
    f32x4* xr = (f32x4*)xrow + lane; const f32x4* gr = (const f32x4*)gain + lane;
    f32x4 v[8]; float s = 0.f;
#pragma unroll
    for (int j = 0; j < 8; ++j) { v[j] = xr[64 * j]; s += (v[j].x * v[j].x + v[j].y * v[j].y) + (v[j].z * v[j].z + v[j].w * v[j].w); }
    const float rs = rsqrtf(wave_sum(s) * (1.f / D) + EPS);
#pragma unroll
    for (int j = 0; j < 8; ++j) { const f32x4 g = gr[64 * j]; xr[64 * j] = v[j] * rs * g; }
}

__device__ __forceinline__ void rms_row_add_bf16(const float* xrow, const bf16_t* mrow, const float* gain, bf16_t* orow, int lane) {
    const f32x4* xr = (const f32x4*)xrow + lane; const u32x2* mr = (const u32x2*)mrow + lane; const f32x4* gr = (const f32x4*)gain + lane;
    f32x4 v[8]; float s = 0.f;
#pragma unroll
    for (int j = 0; j < 8; ++j) { const u32x2 mm = mr[64 * j]; v[j] = xr[64 * j]; v[j].x += bflo(mm.x); v[j].y += bfhi(mm.x); v[j].z += bflo(mm.y); v[j].w += bfhi(mm.y);
        s += (v[j].x * v[j].x + v[j].y * v[j].y) + (v[j].z * v[j].z + v[j].w * v[j].w); }
    const float rs = rsqrtf(wave_sum(s) * (1.f / D) + EPS);
    u32x2* o8 = (u32x2*)orow + lane;
#pragma unroll
    for (int j = 0; j < 8; ++j) { const f32x4 g = gr[64 * j]; u32x2 w; w.x = cvt_pk_bf16(v[j].x * rs * g.x, v[j].y * rs * g.y); w.y = cvt_pk_bf16(v[j].z * rs * g.z, v[j].w * rs * g.w); o8[64 * j] = w; }
}
__device__ __forceinline__ void rms_row_final(const float* xrow, const bf16_t* mrow, const bf16_t* drow, const float* gain, float* orow, int lane) {
    const f32x4* xr = (const f32x4*)xrow + lane; const u32x2* mr = (const u32x2*)mrow + lane; const u32x2* dr = (const u32x2*)drow + lane; const f32x4* gr = (const f32x4*)gain + lane;
    f32x4 v[8]; float s = 0.f;
#pragma unroll
    for (int j = 0; j < 8; ++j) { const u32x2 mm = mr[64 * j], dd = dr[64 * j]; v[j] = xr[64 * j];
        v[j].x += bflo(mm.x) + bflo(dd.x); v[j].y += bfhi(mm.x) + bfhi(dd.x); v[j].z += bflo(mm.y) + bflo(dd.y); v[j].w += bfhi(mm.y) + bfhi(dd.y);
        s += (v[j].x * v[j].x + v[j].y * v[j].y) + (v[j].z * v[j].z + v[j].w * v[j].w); }
    const float rs = rsqrtf(wave_sum(s) * (1.f / D) + EPS);
    f32x4* o = (f32x4*)orow + lane;
#pragma unroll
    for (int j = 0; j < 8; ++j) { const f32x4 g = gr[64 * j]; o[64 * j] = v[j] * rs * g; }
}

struct TrJob { const float* W; int K, N; bf16_t* WT; int ldt, coff; };

__device__ __forceinline__ void phase0(const Frame& F, const Args& a) {
    unsigned char* ws = a.ws;
    LAS float* scr = (LAS float*)(F.lds + F.wave * 16384);
    const int gw = F.bid * 8 + F.wave, NGW = F.G * 8;
    {
        int base = 0;
#define TR(Wp, K_, N_, WTp, ldt_, coff_) { const int ni = ((K_) / 64) * ((N_) / 32); int first = ((gw - base) % NGW + NGW) % NGW; \
            for (int it = first; it < ni; it += NGW) p0_transpose_item((Wp), (N_), (bf16_t*)(WTp), (ldt_), (coff_), scr, it, F.lane); base = (base + ni) % NGW; }
        TR(a.w_in, D, NIN, ws + WS_WIN, D, 0)
        TR(a.w_gate, D, NG, ws + WS_WGATE, D, 0)
        TR(a.w_mem_kv, D, 2048, ws + WS_WMKV, D, 0)
        TR(a.w_o_attn, 512, D, ws + WS_WO, YP, 0)
        TR(a.w_o_lru, 1536, D, ws + WS_WO, YP, 512)
        TR(a.w_o_mem, 1024, D, ws + WS_WO, YP, 2048)
        TR(a.w_out, D, D, ws + WS_WOUT, D, 0)
        TR(a.w_up, D, DFF, ws + WS_WUP, D, 0)
        TR(a.w_down, DFF, D, ws + WS_WDN, DFF, 0)
#undef TR
        for (int it = gw; it < 48 * 8; it += NGW) { const int mat = it >> 3, sub = it & 7; const int which = mat / 24, dn = mat % 24;
            const float* W = (which ? a.lru_wi : a.lru_wa) + (size_t)dn * 16384;
            p0_transpose_item(W, 128, (bf16_t*)(ws + WS_WLRU) + (size_t)(dn * 2 + which) * 16384, 128, 0, scr, sub, F.lane); }
    }
    for (int m = gw; m < M; m += NGW) rms_row_bf16(a.x + (size_t)m * D, a.norm_mix, (bf16_t*)(ws + WS_H) + (size_t)m * D, F.lane);
    for (int m = gw; m < BATCH * NMEM; m += NGW) rms_row_bf16(a.mem + (size_t)m * D, a.norm_mem, (bf16_t*)(ws + WS_MEMN) + (size_t)m * D, F.lane);
    if (F.bid == 1) { for (int i = F.tid; i < M; i += 512) ((float*)(ws + WS_SSQ))[i] = 0.f; }
    if (F.bid == 0) {
        for (int i = F.tid; i < 12 * 129; i += 512) { const int h = i / 129, rel = i % 129 - 64; const int g = h >> 2, d = (g == 0) ? 1 : (g == 1 ? 4 : 16);
            const int off = rel * d; const int n = off < 0 ? -off : off; int bucket = (off > 0) ? 16 : 0;
            if (n < 8) bucket += n; else { int large = 8 + (int)(log((double)n / 8.0) / log(128.0) * 8.0); if (large > 15) large = 15; bucket += large; }
            ((float*)(ws + WS_TAB))[h * 132 + rel + 64] = a.rel_bias[bucket * 12 + h]; }
    }
}

constexpr int AT_PITCH = 272, AT_R1 = 69632, AT_TAB = 139264;
__device__ __forceinline__ s16x4 vtr(const LAS char* p) { return __builtin_bit_cast(s16x4, __builtin_amdgcn_ds_read_tr16_b64_v4i16((LAS s16x4*)p)); }

template <int NCT>
__device__ __forceinline__ void qk_accum(f32x4 (&s)[NCT], const LAS unsigned char* Kt, int key_row0, const bf16x8 (&qf)[4], int fr, int fq) {
#pragma unroll
    for (int ct = 0; ct < NCT; ++ct)
#pragma unroll
        for (int ks = 0; ks < 4; ++ks) { const bf16x8 kf = *(const LAS bf16x8*)(Kt + (key_row0 + 16 * ct + fr) * AT_PITCH + 64 * ks + 16 * fq);
            s[ct] = __builtin_amdgcn_mfma_f32_16x16x32_bf16(kf, qf[ks], s[ct], 0, 0, 0); if (ks == 3 && (ct & 1)) asm volatile("" ::: "memory"); }
}
template <int NKS>
__device__ __forceinline__ void pv_accum(f32x4 (&o)[8], const LAS unsigned char* Vt, int key_row0, const bf16x8 (&pf)[NKS], int fr, int fq) {
#pragma unroll
    for (int ks = 0; ks < NKS; ++ks) {
        const LAS char* p0 = (const LAS char*)Vt + (key_row0 + 32 * ks + 4 * fq + (fr >> 2)) * AT_PITCH + 8 * (fr & 3);
#pragma unroll
        for (int dt = 0; dt < 8; ++dt) { const s16x4 lo = vtr(p0 + 32 * dt), hi = vtr(p0 + 16 * AT_PITCH + 32 * dt);
            const bf16x8 vf = {lo[0], lo[1], lo[2], lo[3], hi[0], hi[1], hi[2], hi[3]};
            o[dt] = __builtin_amdgcn_mfma_f32_16x16x32_bf16(vf, pf[ks], o[dt], 0, 0, 0); }
        asm volatile("" ::: "memory");
    }
}
#define STAGE_TILE(REG, ROWPTR_EXPR) do { _Pragma("unroll") for (int _it = 0; _it < 8; ++_it) { const int _idx = F.tid + 512 * _it; const int i = _idx >> 4, _ch = _idx & 15; \
        const bf16_t* _rp = (ROWPTR_EXPR); u32x4 _v = (u32x4){0u, 0u, 0u, 0u}; if (_rp) _v = *(const u32x4*)(_rp + 8 * _ch); *(LAS u32x4*)((REG) + i * AT_PITCH + 16 * _ch) = _v; } } while (0)

#define STAGE_TILE2(REGA, ROWPTR_A, REGB, ROWPTR_B) do { u32x4 _va[8], _vb[8]; \
        _Pragma("unroll") for (int _it = 0; _it < 8; ++_it) { const int _idx = F.tid + 512 * _it; const int i = _idx >> 4, _ch = _idx & 15; \
            const bf16_t* _rpa = (ROWPTR_A); const bf16_t* _rpb = (ROWPTR_B); _va[_it] = (u32x4){0u, 0u, 0u, 0u}; _vb[_it] = (u32x4){0u, 0u, 0u, 0u}; \
            if (_rpa) _va[_it] = *(const u32x4*)(_rpa + 8 * _ch); if (_rpb) _vb[_it] = *(const u32x4*)(_rpb + 8 * _ch); } \
        _Pragma("unroll") for (int _it = 0; _it < 8; ++_it) { const int _idx = F.tid + 512 * _it; const int i = _idx >> 4, _ch = _idx & 15; \
            *(LAS u32x4*)((REGA) + i * AT_PITCH + 16 * _ch) = _va[_it]; *(LAS u32x4*)((REGB) + i * AT_PITCH + 16 * _ch) = _vb[_it]; } } while (0)

__device__ __forceinline__ void attnA_item(const Frame& F, const Args& a, int item) {
    const bf16_t* proj = (const bf16_t*)(a.ws + WS_PROJ);
    const int b = item / 384, rem = item % 384, h = rem >> 5, q = rem & 31, g = h >> 2, hh = h & 3;
    const int dsh = 2 * g, d = 1 << dsh, L = SEQ >> dsh, npairs = 32 >> dsh, r = q / npairs, n0 = 2 * (q % npairs);
    const int fr = F.lane & 15, fq = F.lane >> 4, hb = F.wave >> 2;
    const size_t rowbase = (size_t)b * SEQ;
    const int kp0 = (n0 - 1) * 64;
    LAS unsigned char* R0 = F.lds; LAS unsigned char* R1 = F.lds + AT_R1; LAS float* tab = (LAS float*)(F.lds + AT_TAB);
    __syncthreads();
    STAGE_TILE2(R0, ((kp0 + i >= 0 && kp0 + i < L) ? proj + (rowbase + (size_t)(kp0 + i) * d + r) * NIN + C_K + h * 128 : (const bf16_t*)nullptr),
                R1, ((kp0 + i >= 0 && kp0 + i < L) ? proj + (rowbase + (size_t)(kp0 + i) * d + r) * NIN + C_V + h * 128 : (const bf16_t*)nullptr));
    if (F.tid < 129) tab[F.tid] = ((const float*)(a.ws + WS_TAB))[h * 132 + F.tid];
    const int qq = 16 * (F.wave & 3) + fr;
    const int qpos = (n0 + hb) * 64 + qq;
    const size_t qrow = rowbase + (size_t)qpos * d + r;
    bf16x8 qf[4];
#pragma unroll
    for (int ks = 0; ks < 4; ++ks) qf[ks] = *(const bf16x8*)(proj + qrow * NIN + C_Q + h * 128 + 32 * ks + 8 * fq);
    __syncthreads();
    f32x4 s[12];
#pragma unroll
    for (int ct = 0; ct < 12; ++ct) s[ct] = (f32x4){0.f, 0.f, 0.f, 0.f};
    qk_accum<12>(s, R0, 64 * hb, qf, fr, fq);
    const float scale = 0.08838834764831845f;
    const int kpw = (n0 + hb - 1) * 64;
    float mx = -3.0e38f;
#pragma unroll
    for (int ct = 0; ct < 12; ++ct)
#pragma unroll
        for (int j = 0; j < 4; ++j) { const int kk = 16 * ct + 4 * fq + j; const int rel = kk - 64 - qq; const int kp = kpw + kk;
            const bool valid = (rel >= -64) && (rel <= 64) && (kp >= 0) && (kp < L);
            const float bias = tab[valid ? rel + 64 : 64];
            const float l = valid ? s[ct][j] * scale + bias : -1e30f; s[ct][j] = l; mx = fmaxf(mx, l); }
    mx = fmaxf(mx, __shfl_xor(mx, 16)); mx = fmaxf(mx, __shfl_xor(mx, 32));
    float sum = 0.f;
#pragma unroll
    for (int ct = 0; ct < 12; ++ct)
#pragma unroll
        for (int j = 0; j < 4; ++j) { const float p = __expf(s[ct][j] - mx); s[ct][j] = p; sum += p; }
    sum += __shfl_xor(sum, 16); sum += __shfl_xor(sum, 32);
    bf16x8 pf[6];
#pragma unroll
    for (int ks = 0; ks < 6; ++ks) { u32x4 w; w.x = cvt_pk_bf16(s[2 * ks][0], s[2 * ks][1]); w.y = cvt_pk_bf16(s[2 * ks][2], s[2 * ks][3]);
        w.z = cvt_pk_bf16(s[2 * ks + 1][0], s[2 * ks + 1][1]); w.w = cvt_pk_bf16(s[2 * ks + 1][2], s[2 * ks + 1][3]); pf[ks] = __builtin_bit_cast(bf16x8, w); }
    f32x4 o[8];
#pragma unroll
    for (int dt = 0; dt < 8; ++dt) o[dt] = (f32x4){0.f, 0.f, 0.f, 0.f};
    pv_accum<6>(o, R1, 64 * hb, pf, fr, fq);
    const float inv = 1.0f / sum;
    bf16_t* orow = (g == 0) ? (bf16_t*)a.out + qrow * YP + hh * 128 : (bf16_t*)((unsigned char*)a.out + DO_O12) + qrow * 1024 + (g - 1) * 512 + hh * 128;
#pragma unroll
    for (int dt = 0; dt < 8; ++dt) { u32x2 w; w.x = cvt_pk_bf16(o[dt][0] * inv, o[dt][1] * inv); w.y = cvt_pk_bf16(o[dt][2] * inv, o[dt][3] * inv); *(u32x2*)(orow + 16 * dt + 4 * fq) = w; }
    if (fq == 0) ((float*)(a.ws + WS_LSE))[qrow * 12 + h] = mx + __logf(sum);
}

__device__ __forceinline__ void attnC_item(const Frame& F, const Args& a, int item) {
    const bf16_t* proj = (const bf16_t*)(a.ws + WS_PROJ); const bf16_t* kv = (const bf16_t*)(a.ws + WS_KV);
    const int b = item >> 7, head = (item >> 5) & 3, qb = item & 31;
    const int fr = F.lane & 15, fq = F.lane >> 4;
    LAS unsigned char* R0 = F.lds; LAS unsigned char* R1 = F.lds + AT_R1;
    const size_t qrow = (size_t)b * SEQ + qb * 128 + 16 * F.wave + fr;
    const bf16_t* kbase = kv + (size_t)b * NMEM * 2048 + head * 256;
    __syncthreads();
    STAGE_TILE2(R0, (kbase + (size_t)i * 2048), R1, (kbase + (size_t)i * 2048 + 128));
    bf16x8 qf[4];
    f32x4 s[16];
#pragma unroll
    for (int ct = 0; ct < 16; ++ct) s[ct] = (f32x4){0.f, 0.f, 0.f, 0.f};
#pragma unroll
    for (int ks = 0; ks < 4; ++ks) qf[ks] = *(const bf16x8*)(proj + qrow * NIN + C_QC + head * 256 + 32 * ks + 8 * fq);
    __syncthreads();
    qk_accum<16>(s, R0, 0, qf, fr, fq);
#pragma unroll
    for (int ks = 0; ks < 4; ++ks) qf[ks] = *(const bf16x8*)(proj + qrow * NIN + C_QC + head * 256 + 128 + 32 * ks + 8 * fq);
    qk_accum<16>(s, R1, 0, qf, fr, fq);
    float mx = -3.0e38f;
#pragma unroll
    for (int ct = 0; ct < 16; ++ct)
#pragma unroll
        for (int j = 0; j < 4; ++j) { const float l = s[ct][j] * 0.0625f; s[ct][j] = l; mx = fmaxf(mx, l); }
    mx = fmaxf(mx, __shfl_xor(mx, 16)); mx = fmaxf(mx, __shfl_xor(mx, 32));
    float sum = 0.f;
#pragma unroll
    for (int ct = 0; ct < 16; ++ct)
#pragma unroll
        for (int j = 0; j < 4; ++j) { const float p = __expf(s[ct][j] - mx); s[ct][j] = p; sum += p; }
    sum += __shfl_xor(sum, 16); sum += __shfl_xor(sum, 32);
    bf16x8 pf[8];
#pragma unroll
    for (int ks = 0; ks < 8; ++ks) { u32x4 w; w.x = cvt_pk_bf16(s[2 * ks][0], s[2 * ks][1]); w.y = cvt_pk_bf16(s[2 * ks][2], s[2 * ks][3]);
        w.z = cvt_pk_bf16(s[2 * ks + 1][0], s[2 * ks + 1][1]); w.w = cvt_pk_bf16(s[2 * ks + 1][2], s[2 * ks + 1][3]); pf[ks] = __builtin_bit_cast(bf16x8, w); }
    __syncthreads();
    STAGE_TILE2(R0, (kbase + (size_t)i * 2048 + 1024), R1, (kbase + (size_t)i * 2048 + 1024 + 128));
    __syncthreads();
    const float inv = 1.0f / sum;
    bf16_t* orow = (bf16_t*)a.out + qrow * YP + 2048 + head * 256;
#pragma unroll
    for (int half = 0; half < 2; ++half) {
        f32x4 o[8];
#pragma unroll
        for (int dt = 0; dt < 8; ++dt) o[dt] = (f32x4){0.f, 0.f, 0.f, 0.f};
        pv_accum<8>(o, half ? R1 : R0, 0, pf, fr, fq);
#pragma unroll
        for (int dt = 0; dt < 8; ++dt) { u32x2 w; w.x = cvt_pk_bf16(o[dt][0] * inv, o[dt][1] * inv); w.y = cvt_pk_bf16(o[dt][2] * inv, o[dt][3] * inv); *(u32x2*)(orow + 128 * half + 16 * dt + 4 * fq) = w; }
    }
}

__device__ __forceinline__ void combine_row(const Args& a, size_t row, int lane) {
    bf16_t* y = (bf16_t*)a.out + row * YP + 8 * lane; const bf16_t* o12 = (const bf16_t*)((unsigned char*)a.out + DO_O12) + row * 1024 + 8 * lane;
    const float* lse = (const float*)(a.ws + WS_LSE) + row * 12; const int hh = lane >> 4;
    const float l0 = lse[hh], l1 = lse[4 + hh], l2 = lse[8 + hh]; const float mx = fmaxf(l0, fmaxf(l1, l2));
    float w0 = __expf(l0 - mx), w1 = __expf(l1 - mx), w2 = __expf(l2 - mx); const float inv = 1.0f / (w0 + w1 + w2); w0 *= inv; w1 *= inv; w2 *= inv;
    const u32x4 v0 = *(const u32x4*)y, v1 = *(const u32x4*)o12, v2 = *(const u32x4*)(o12 + 512);
    u32x4 w;
    w.x = cvt_pk_bf16(w0 * bflo(v0.x) + w1 * bflo(v1.x) + w2 * bflo(v2.x), w0 * bfhi(v0.x) + w1 * bfhi(v1.x) + w2 * bfhi(v2.x));
    w.y = cvt_pk_bf16(w0 * bflo(v0.y) + w1 * bflo(v1.y) + w2 * bflo(v2.y), w0 * bfhi(v0.y) + w1 * bfhi(v1.y) + w2 * bfhi(v2.y));
    w.z = cvt_pk_bf16(w0 * bflo(v0.z) + w1 * bflo(v1.z) + w2 * bflo(v2.z), w0 * bfhi(v0.z) + w1 * bfhi(v1.z) + w2 * bfhi(v2.z));
    w.w = cvt_pk_bf16(w0 * bflo(v0.w) + w1 * bflo(v1.w) + w2 * bflo(v2.w), w0 * bfhi(v0.w) + w1 * bfhi(v1.w) + w2 * bfhi(v2.w));
    *(u32x4*)y = w;
}

constexpr int LR_AT = 70656;
__device__ __forceinline__ int lru_perm(int t) { return (t & ~63) | ((t & 12) << 2) | ((t & 48) >> 2) | (t & 3); }
__device__ __forceinline__ float fsig(float x) { return __builtin_amdgcn_rcpf(1.0f + __expf(-x)); }
template <bool PASS2>
__device__ __forceinline__ void lru_item(const Frame& F, const Args& a, int item) {
    const bf16_t* proj = (const bf16_t*)(a.ws + WS_PROJ);
    const int n = item % 12, chunk = (item / 12) % NCHUNK, b = item / (12 * NCHUNK);
    const int t0 = chunk * CHUNK; const size_t rowbase = (size_t)b * SEQ;
    const int fr = F.lane & 15, fq = F.lane >> 4, w = F.wave;
    const int c = 16 * w + fr, cg_ = n * 128 + c;
    const int cch = F.tid & 15, r0 = F.tid >> 4;
    LAS unsigned char* R0 = F.lds; LAS unsigned char* AT = F.lds + LR_AT;
    __syncthreads();
    for (int idx = F.tid; idx < 259 * 16; idx += 512) { const int row = idx >> 4, ch = idx & 15; const int t = t0 - 1 + row; u32x4 v = (u32x4){0u, 0u, 0u, 0u};
        if (t >= 0 && t < SEQ) v = *(const u32x4*)(proj + (rowbase + t) * NIN + C_XB + n * 128 + 8 * ch);
        *(LAS u32x4*)(R0 + row * AT_PITCH + 16 * ch) = v; }
    {
        f32x4 cw[4][2], cbv[2];
#pragma unroll
        for (int j = 0; j < 4; ++j) { cw[j][0] = *(const f32x4*)(a.conv_w + j * 1536 + n * 128 + 8 * cch); cw[j][1] = *(const f32x4*)(a.conv_w + j * 1536 + n * 128 + 8 * cch + 4); }
        cbv[0] = *(const f32x4*)(a.conv_b + n * 128 + 8 * cch); cbv[1] = *(const f32x4*)(a.conv_b + n * 128 + 8 * cch + 4);
        u32x4 ybv[8];
        if (PASS2) {
#pragma unroll
            for (int it = 0; it < 8; ++it) ybv[it] = *(const u32x4*)(proj + (rowbase + t0 + r0 + 32 * it) * NIN + C_YB + n * 128 + 8 * cch);
        }
        __syncthreads();
#pragma unroll 2
        for (int it = 0; it < 8; ++it) { const int tl = r0 + 32 * it;
            f32x4 x0 = cbv[0], x1 = cbv[1];
#pragma unroll
            for (int j = 0; j < 4; ++j) { const u32x4 v = *(const LAS u32x4*)(R0 + (tl + j) * AT_PITCH + 16 * cch);
                x0[0] += cw[j][0][0] * bflo(v.x); x0[1] += cw[j][0][1] * bfhi(v.x); x0[2] += cw[j][0][2] * bflo(v.y); x0[3] += cw[j][0][3] * bfhi(v.y);
                x1[0] += cw[j][1][0] * bflo(v.z); x1[1] += cw[j][1][1] * bfhi(v.z); x1[2] += cw[j][1][2] * bflo(v.w); x1[3] += cw[j][1][3] * bfhi(v.w); }
            u32x4 o; o.x = cvt_pk_bf16(x0[0], x0[1]); o.y = cvt_pk_bf16(x0[2], x0[3]); o.z = cvt_pk_bf16(x1[0], x1[1]); o.w = cvt_pk_bf16(x1[2], x1[3]);
            *(LAS u32x4*)(AT + lru_perm(tl) * AT_PITCH + 16 * cch) = o; }
        __syncthreads();
        if (PASS2) {
#pragma unroll
            for (int it = 0; it < 8; ++it) *(LAS u32x4*)(R0 + (r0 + 32 * it) * AT_PITCH + 16 * cch) = ybv[it];
        }
    }
    bf16x8 sel;
    { const bool mine = (fq == 2 * (w & 1) + (fr >> 3));
#pragma unroll
      for (int jj = 0; jj < 8; ++jj) sel[jj] = (mine && jj == (fr & 7)) ? (short)0x3F80 : (short)0; }
    const int ks0 = w >> 1;
    float hf[4][4][4];
#pragma unroll
    for (int i0 = 0; i0 < 4; ++i0)
#pragma unroll
        for (int i1 = 0; i1 < 4; ++i1)
#pragma unroll
            for (int i2 = 0; i2 < 4; ++i2) hf[i0][i1][i2] = 0.f;
    auto dir_body = [&](auto dirc) __attribute__((always_inline)) { constexpr int dir = decltype(dirc)::value;
        const bf16_t* wt = (const bf16_t*)(a.ws + WS_WLRU) + (size_t)((dir * 12 + n) * 2) * 16384 + (size_t)c * 128 + 8 * fq;
        bf16x8 wrf[4], wif[4];
#pragma unroll
        for (int ks = 0; ks < 4; ++ks) { wrf[ks] = *(const bf16x8*)(wt + 32 * ks); wif[ks] = *(const bf16x8*)(wt + 16384 + 32 * ks); }
        const float ba = a.lru_ba[dir * 1536 + cg_], bi = a.lru_bi[dir * 1536 + cg_];
        const float lam = a.lru_lambda[dir * 1536 + cg_];
        const float logu = -8.0f * log1pf(__expf(-lam));
        float hc = 0.f, TA = 1.f, TB = 0.f;
        if (PASS2) { const f32x2* ag = (const f32x2*)(a.ws + WS_AGG) + ((size_t)(b * NCHUNK) * 2 + dir) * 1536 + cg_;
            f32x2 pa[NCHUNK];
#pragma unroll
            for (int cc = 0; cc < NCHUNK; ++cc) pa[cc] = ag[(size_t)cc * 2 * 1536];
#pragma unroll
            for (int i = 0; i < NCHUNK; ++i) { const int cc = dir ? NCHUNK - 1 - i : i; const bool use = dir ? (cc > chunk) : (cc < chunk); if (use) hc = pa[cc].x * hc + pa[cc].y; } }
        const int tstart = dir ? SEQ - 1 : 0;
        if (dir == 1) __syncthreads();
#pragma unroll 1
        for (int si = 0; si < 4; ++si) { const int s = dir ? 3 - si : si;
            if (PASS2 && dir == 0) {
#pragma unroll
                for (int i1 = 0; i1 < 4; ++i1)
#pragma unroll
                    for (int i2 = 0; i2 < 4; ++i2) { hf[0][i1][i2] = hf[1][i1][i2]; hf[1][i1][i2] = hf[2][i1][i2]; hf[2][i1][i2] = hf[3][i1][i2]; } }
            f32x4 ar[4], ai[4], ax[4];
#pragma unroll
            for (int rt = 0; rt < 4; ++rt) { ar[rt] = (f32x4){0.f, 0.f, 0.f, 0.f}; ai[rt] = (f32x4){0.f, 0.f, 0.f, 0.f}; ax[rt] = (f32x4){0.f, 0.f, 0.f, 0.f};
#pragma unroll
                for (int ks = 0; ks < 4; ++ks) { const bf16x8 xf = *(const LAS bf16x8*)(AT + (64 * s + 16 * rt + fr) * AT_PITCH + 64 * ks + 16 * fq);
                    ar[rt] = __builtin_amdgcn_mfma_f32_16x16x32_bf16(xf, wrf[ks], ar[rt], 0, 0, 0); ai[rt] = __builtin_amdgcn_mfma_f32_16x16x32_bf16(xf, wif[ks], ai[rt], 0, 0, 0);
                    if (ks == ks0) ax[rt] = __builtin_amdgcn_mfma_f32_16x16x32_bf16(xf, sel, ax[rt], 0, 0, 0); } }
            const int tl0 = 64 * s + 16 * fq;
            float A16 = 1.f, B16 = 0.f;
#pragma unroll
            for (int e = 0; e < 16; ++e) { const int ee = dir ? 15 - e : e; const int rt = ee >> 2, j = ee & 3;
                const float rg = fsig(ar[rt][j] + ba), ig = fsig(ai[rt][j] + bi); const float la = logu * rg; const float av = __expf(la);
                const float mult = (t0 + tl0 + ee == tstart) ? 1.0f : __builtin_amdgcn_sqrtf(fmaxf(1.0f - av * av, 0.f)); const float bv = mult * ig * ax[rt][j];
                ar[rt][j] = av; ai[rt][j] = bv; B16 = av * B16 + bv; A16 = av * A16; }
            const int pos = dir ? 3 - fq : fq;
            float PA = 1.f, PB = 0.f, QA = 1.f, QB = 0.f;
#pragma unroll
            for (int i = 0; i < 4; ++i) { const int k = dir ? 3 - i : i; const float Ak = __shfl(A16, fr + 16 * k), Bk = __shfl(B16, fr + 16 * k);
                if (i < pos) { PB = Ak * PB + Bk; PA = Ak * PA; }
                QB = Ak * QB + Bk; QA = Ak * QA; }
            if (PASS2) {
                float h = PA * hc + PB;
#pragma unroll
                for (int e = 0; e < 16; ++e) { const int ee = dir ? 15 - e : e; const int rt = ee >> 2, j = ee & 3; h = ar[rt][j] * h + ai[rt][j];
                    if (dir == 0) hf[3][rt][j] = h;
                    else { LAS unsigned short* yp = (LAS unsigned short*)(R0 + (tl0 + ee) * AT_PITCH + 2 * c); const float yb = bf2f(*yp);
                        const float u2 = 1.5957691216057308f * (yb + 0.044715f * yb * yb * yb);
                        const float y = (hf[3][rt][j] + h) * yb * fsig(u2);
                        *yp = (unsigned short)(cvt_pk_bf16(y, 0.f) & 0xffffu); } }
                hc = QA * hc + QB;
            } else { TB = QA * TB + QB; TA = QA * TA; }
            if (PASS2 && dir == 1) {
#pragma unroll
                for (int i1 = 0; i1 < 4; ++i1)
#pragma unroll
                    for (int i2 = 0; i2 < 4; ++i2) { hf[3][i1][i2] = hf[2][i1][i2]; hf[2][i1][i2] = hf[1][i1][i2]; hf[1][i1][i2] = hf[0][i1][i2]; } }
        }
        if (!PASS2 && fq == 0) ((f32x2*)(a.ws + WS_AGG))[((size_t)(b * NCHUNK + chunk) * 2 + dir) * 1536 + cg_] = (f32x2){TA, TB};
        };
    dir_body(std::integral_constant<int, 0>{});
    dir_body(std::integral_constant<int, 1>{});
    if (PASS2) {
        __syncthreads();
#pragma unroll
        for (int it = 0; it < 8; ++it) { const int tl = r0 + 32 * it;
            *(u32x4*)((bf16_t*)a.out + (rowbase + t0 + tl) * YP + 512 + n * 128 + 8 * cch) = *(const LAS u32x4*)(R0 + tl * AT_PITCH + 16 * cch); }
    }
}

#define XB_TMO      128
#define XB_XCNT(j)  (256  + 64 * (j))
#define XB_XSUB(j)  (1280 + 64 * (j))
#define XB_XGEN(j)  (2304 + 64 * (j))
#define XB_TOP      3328
#define XB_TOPGEN   3392
#define XCD_BAR_WORDS 3456
#define XB_SPIN_CAP (1u << 18)

__device__ __forceinline__ unsigned xb_ld(unsigned* p)              { return __hip_atomic_load(p, __ATOMIC_RELAXED, __HIP_MEMORY_SCOPE_AGENT); }
__device__ __forceinline__ unsigned xb_add(unsigned* p, unsigned v) { return __hip_atomic_fetch_add(p, v, __ATOMIC_RELAXED, __HIP_MEMORY_SCOPE_AGENT); }
__device__ __forceinline__ unsigned xb_xcc_id() { return (unsigned)__builtin_amdgcn_s_getreg((3 << 11) | 20) & 0xFu; }
#define XB_SPIN(cond, bar) do { unsigned _sp = 0; while (cond) { __builtin_amdgcn_s_sleep(1); \
    if ((++_sp & 255u) == 0u) { if (xb_ld(&(bar)[XB_TMO])) break; if (_sp > XB_SPIN_CAP) { atomicAdd(&(bar)[XB_TMO], 1u); break; } } } } while (0)

struct XcdBarrier {
    unsigned* bar; unsigned x;
    volatile LAS unsigned* st;
};

__device__ __forceinline__ XcdBarrier xcd_barrier_post(unsigned* bar, volatile LAS unsigned* st) {
    XcdBarrier b; b.bar = bar; b.x = xb_xcc_id(); b.st = st;
    if (threadIdx.x == 0) (void)xb_add(&bar[XB_XCNT(b.x)], 1u);
    return b;
}
__device__ __forceinline__ void xcd_barrier_complete(unsigned* bar, unsigned x, unsigned& nloc, unsigned& nx) {
    const unsigned G = gridDim.x * gridDim.y * gridDim.z;
    unsigned sum, cnt, mine, sp = 0u;
    for (;;) {
        sum = 0u; cnt = 0u; mine = 0u;
#pragma unroll
        for (unsigned j = 0; j < 16; ++j) { const unsigned c = xb_ld(&bar[XB_XCNT(j)]); sum += c; cnt += (c > 0u) ? 1u : 0u; mine = (j == x) ? c : mine; }
        if (sum == G) break;
        __builtin_amdgcn_s_sleep(1);
        if ((++sp & 255u) == 0u) { if (xb_ld(&bar[XB_TMO])) break; if (sp > XB_SPIN_CAP) { atomicAdd(&bar[XB_TMO], 1u); break; } }
    }
    nloc = mine > 0u ? mine : 1u; nx = cnt > 0u ? cnt : 1u;
}

__device__ __forceinline__ void xcd_barrier(const XcdBarrier& b) {
    asm volatile("s_waitcnt vmcnt(0)" ::: "memory");
    __syncthreads();
    if (threadIdx.x == 0) {
        unsigned* bar = b.bar;
        __builtin_amdgcn_s_waitcnt(0);
        unsigned nloc = b.st[0], nx = b.st[1];
        if (nloc == 0u) { xcd_barrier_complete(bar, b.x, nloc, nx); b.st[0] = nloc; b.st[1] = nx; }
        const unsigned old = xb_add(&bar[XB_XSUB(b.x)], 1u);
        const unsigned gen = old / nloc;
        if (old + 1u == (gen + 1u) * nloc) {
            __builtin_amdgcn_fence(__ATOMIC_RELEASE, "agent");
            asm volatile("s_waitcnt vmcnt(0)" ::: "memory");
            const unsigned og = xb_add(&bar[XB_TOP], 1u);
            if (og + 1u == (gen + 1u) * nx) xb_add(&bar[XB_TOPGEN], 1u);
        }
        XB_SPIN(xb_ld(&bar[XB_TOPGEN]) == gen, bar);
        __builtin_amdgcn_fence(__ATOMIC_ACQUIRE, "agent");
        asm volatile("s_waitcnt vmcnt(0)" ::: "memory");
    }
    __syncthreads();
}

__global__ void __launch_bounds__(512, 2) mega_fwd(Args a) {
    extern __shared__ __attribute__((aligned(16))) unsigned char lds_raw[];
    Frame F; F.lds = (LAS unsigned char*)lds_raw; F.tid = threadIdx.x; F.lane = F.tid & 63; F.wave = __builtin_amdgcn_readfirstlane(F.tid >> 6); F.G = gridDim.x; F.bid = blockIdx.x;
    cg::grid_group grid = cg::this_grid();
    unsigned char* ws = a.ws;
    const int lo = a.ph_lo, hi = a.ph_hi;
#ifndef REP_MASK
#define REP_MASK 0
#endif
#define NREP(k) ((((REP_MASK) >> (k)) & 1) ? 2 : 1)
#ifndef SUB_MASK
#define SUB_MASK 7
#endif
#ifndef PH_MASK
#define PH_MASK 0x7ff
#endif
#define IN(k) ((((PH_MASK) >> (k)) & 1) && lo <= (k) && (k) < hi)
#define SEAM(k) do { if (IN(k) && IN((k) + 1)) xcd_barrier(xbar); } while (0)
    const int gw = F.bid * 8 + F.wave, NGW = F.G * 8;
    if (F.tid < 2) ((volatile LAS unsigned*)(F.lds + LDS_XB))[F.tid] = 0u;
    __syncthreads();
    if (F.bid == 0) { for (int i = F.tid; i < XCD_BAR_WORDS; i += 512) __hip_atomic_store((unsigned*)(ws + WS_BAR) + i, 0u, __ATOMIC_RELAXED, __HIP_MEMORY_SCOPE_AGENT); }
    XcdBarrier xbar; xbar.bar = (unsigned*)(ws + WS_BAR); xbar.x = 0; xbar.st = (volatile LAS unsigned*)(F.lds + LDS_XB);

    if (IN(0)) for (int rep = 0; rep < NREP(0); ++rep) { phase0(F, a); if (rep + 1 < NREP(0)) __syncthreads(); }
    if (IN(0) && IN(1)) { grid.sync(); xbar = xcd_barrier_post((unsigned*)(ws + WS_BAR), (volatile LAS unsigned*)(F.lds + LDS_XB)); }
    if (IN(1)) {
        { pg8::Gemm g{(const bf16_t*)(ws + WS_H), (const bf16_t*)(ws + WS_WIN), M, NIN, D, D, D}; pg8::StaticOrder S; S.init(M, NIN, F.G, F.bid, NREP(1));
          pg8::EpiBf16<0> E{(bf16_t*)(ws + WS_PROJ), NIN, nullptr}; pg8::gemm_phase(F.lds, g, S, E); }
        { pg8::Gemm g{(const bf16_t*)(ws + WS_MEMN), (const bf16_t*)(ws + WS_WMKV), BATCH * NMEM, 2048, D, D, D}; pg8::StaticOrder S; S.init(BATCH * NMEM, 2048, 32, F.bid >= F.G - 32 ? F.bid - (F.G - 32) : -1);
          pg8::EpiBf16<0> E{(bf16_t*)(ws + WS_KV), 2048, nullptr}; pg8::gemm_phase(F.lds, g, S, E); }
    }
    SEAM(1);
    if (IN(2)) {
        constexpr int N_L = BATCH * NCHUNK * 12, N_A = BATCH * 12 * 32, N_C = BATCH * 4 * 32;
        if (F.bid & 1) {
            for (int it = F.bid; it < N_L; it += F.G) lru_item<false>(F, a, it);
            for (int it = F.bid; it < N_A; it += F.G) attnA_item(F, a, it);
            for (int it = F.bid; it < N_C; it += F.G) attnC_item(F, a, it);
        } else {
            for (int it = F.bid; it < N_A; it += F.G) attnA_item(F, a, it);
            for (int it = F.bid; it < N_C; it += F.G) attnC_item(F, a, it);
            for (int it = F.bid; it < N_L; it += F.G) lru_item<false>(F, a, it);
        }
    }
    SEAM(2);
    if (IN(3)) {
        constexpr int N_L2 = BATCH * NCHUNK * 12;
        const bool gemm_first = ((F.bid >> 3) & 1) == 0;
#define P3_GEMM() do { __syncthreads(); pg8::Gemm g{(const bf16_t*)(ws + WS_H), (const bf16_t*)(ws + WS_WGATE), M, NG, D, D, D}; pg8::StaticOrder S; S.init(M, NG, F.G, F.bid); \
            pg8::EpiGate8 E{ws + WS_PROJ, a.b_gate}; pg8::gemm_phase(F.lds, g, S, E); } while (0)
#define P3_LRU() do { for (int it = F.bid; it < N_L2; it += F.G) lru_item<true>(F, a, it); for (int m = gw; m < M; m += NGW) combine_row(a, (size_t)m, F.lane); } while (0)
        if (gemm_first) { P3_GEMM(); P3_LRU(); } else { P3_LRU(); P3_GEMM(); }
#undef P3_GEMM
#undef P3_LRU
    }
    SEAM(3);
    if (IN(5)) {
        pg8::Gemm g{(const bf16_t*)a.out, (const bf16_t*)(ws + WS_WO), M, D, YP, YP, YP}; pg8::StaticOrder S; S.init(M, D, F.G, F.bid, NREP(5));
        pg8::EpiMix E{(bf16_t*)(ws + WS_H), ws + WS_PROJ}; pg8::gemm_phase(F.lds, g, S, E);
    }
    SEAM(5);
    if (IN(6)) {
        pg8::Gemm g{(const bf16_t*)(ws + WS_H), (const bf16_t*)(ws + WS_WOUT), M, D, D, D, D}; pg8::StaticOrder S; S.init(M, D, F.G, F.bid, NREP(6));
        pg8::EpiBf16<0> E{(bf16_t*)(ws + WS_H2), D, nullptr}; pg8::gemm_phase(F.lds, g, S, E);
    }
    SEAM(6);
    if (IN(7)) { for (int m = gw; m < M; m += NGW) rms_row_add_bf16(a.x + (size_t)m * D, (const bf16_t*)(ws + WS_H2) + (size_t)m * D, a.norm_mlp, (bf16_t*)(ws + WS_H) + (size_t)m * D, F.lane); }
    SEAM(7);
    if (IN(8)) {
        pg8::Gemm g{(const bf16_t*)(ws + WS_H), (const bf16_t*)(ws + WS_WUP), M, DFF, D, D, D}; pg8::StaticOrder S; S.init(M, DFF, F.G, F.bid, NREP(8));
        pg8::EpiBf16<2> E{(bf16_t*)(ws + WS_PROJ), DFF, nullptr}; pg8::gemm_phase(F.lds, g, S, E);
    }
    SEAM(8);
    if (IN(9)) {
        pg8::Gemm g{(const bf16_t*)(ws + WS_PROJ), (const bf16_t*)(ws + WS_WDN), M, D, DFF, DFF, DFF}; pg8::StaticOrder S; S.init(M, D, F.G, F.bid, NREP(9), 4);
        pg8::EpiBf16<0> E{(bf16_t*)(ws + WS_H), D, nullptr}; pg8::gemm_phase(F.lds, g, S, E);
    }
    SEAM(9);
    if (IN(10)) { for (int m = gw; m < M; m += NGW) rms_row_final(a.x + (size_t)m * D, (const bf16_t*)(ws + WS_H2) + (size_t)m * D, (const bf16_t*)(ws + WS_H) + (size_t)m * D, a.norm_final, a.out + (size_t)m * D, F.lane); }
#undef IN
#undef SEAM
}

#ifndef MK_SPLIT
#define MK_SPLIT 0
#endif
extern "C" void kernel_launch(void* const* d_in, const int* in_sizes, int n_in, void* d_out, int out_size, void* d_ws, size_t ws_size, hipStream_t stream) {
    static int grid = 0;
    if (grid == 0) {
        if (n_in != 24 || in_sizes[0] != M * D || out_size != M * D || ws_size < WS_END) { fprintf(stderr, "kernel_launch: unexpected shapes (n_in %d, in0 %d, out %d, ws %zu); nothing launched\n", n_in, n_in > 0 ? in_sizes[0] : -1, out_size, ws_size); grid = -1; return; }
        int dev = 0, cus = 0, per_cu = 0;
        (void)hipGetDevice(&dev); (void)hipDeviceGetAttribute(&cus, hipDeviceAttributeMultiprocessorCount, dev);
        if (hipFuncSetAttribute((const void*)mega_fwd, hipFuncAttributeMaxDynamicSharedMemorySize, LDS_BYTES) != hipSuccess) { fprintf(stderr, "kernel_launch: hipFuncSetAttribute failed\n"); grid = -1; return; }
        if (hipOccupancyMaxActiveBlocksPerMultiprocessor(&per_cu, (const void*)mega_fwd, 512, LDS_BYTES) != hipSuccess || per_cu < 1) { fprintf(stderr, "kernel_launch: occupancy query says %d blocks per CU\n", per_cu); (void)hipGetLastError(); }
        grid = cus > 0 ? cus : 256;
    }
    if (grid < 0) return;
    Args a{};
    const float** p = (const float**)&a;
    for (int i = 0; i < 24; ++i) p[i] = (const float*)d_in[i];
    a.out = (float*)d_out; a.ws = (unsigned char*)d_ws;
#if MK_SPLIT
    for (int ph = 0; ph < 11; ++ph) { a.ph_lo = ph; a.ph_hi = ph + 1; hipLaunchKernelGGL(mega_fwd, dim3(grid), dim3(512), LDS_BYTES, stream, a); }
#else
    a.ph_lo = 0; a.ph_hi = 11;
    void* args[] = {&a};
    hipError_t e = hipLaunchCooperativeKernel((const void*)mega_fwd, dim3(grid), dim3(512), args, LDS_BYTES, stream);
    if (e != hipSuccess) fprintf(stderr, "kernel_launch: cooperative launch failed: %s (grid %d)\n", hipGetErrorString(e), grid);
#endif
}
```

```cpp
#include <hip/hip_runtime.h>
#include <hip/hip_cooperative_groups.h>
#include <cstdio>
#include <cstdint>
#include <type_traits>
namespace cg = cooperative_groups;

#define LAS __attribute__((address_space(3)))
typedef unsigned short bf16_t;
typedef short bf16x8 __attribute__((ext_vector_type(8)));
typedef short s16x4 __attribute__((ext_vector_type(4)));
typedef float f32x4 __attribute__((ext_vector_type(4)));
typedef float f32x2 __attribute__((ext_vector_type(2)));
typedef unsigned u32x4 __attribute__((ext_vector_type(4)));
typedef unsigned u32x2 __attribute__((ext_vector_type(2)));

constexpr int D = 2048, BATCH = 4, SEQ = 4096, M = BATCH * SEQ;
constexpr int NIN = 8704, NG = 6144, DFF = 8192, NMEM = 256;
constexpr int C_Q = 0, C_K = 1536, C_V = 3072, C_XB = 4608, C_YB = 6144, C_QC = 7680;
constexpr int YP = 3072;
constexpr float EPS = 1e-6f;
constexpr int NCHUNK = 16, CHUNK = 256;

constexpr size_t MiB = 1u << 20;
constexpr size_t WS_TAB = 0;
constexpr size_t WS_BAR = 65536;
constexpr size_t WS_LSE = 1 * MiB;
constexpr size_t WS_AGG = 2 * MiB;
constexpr size_t WS_SSQ = 3 * MiB + 768 * 1024;
constexpr size_t WS_H2 = 14 * MiB;
constexpr size_t WS_WLRU = 4 * MiB;
constexpr size_t WS_MEMN = 6 * MiB;
constexpr size_t WS_KV = 10 * MiB;
constexpr size_t WS_WIN = 14 * MiB;
constexpr size_t WS_WGATE = 48 * MiB;
constexpr size_t WS_WMKV = 72 * MiB;
constexpr size_t WS_WO = 80 * MiB;
constexpr size_t WS_WOUT = 92 * MiB;
constexpr size_t WS_WUP = 100 * MiB;
constexpr size_t WS_WDN = 132 * MiB;
constexpr size_t WS_H = 164 * MiB;
constexpr size_t WS_PROJ = 228 * MiB;
constexpr size_t WS_END = 500 * MiB;
constexpr size_t DO_O12 = 96 * MiB;

constexpr int LDS_BYTES = 147456;
constexpr int LDS_XB = 147456 - 64;

__device__ __forceinline__ unsigned cvt_pk_bf16(float lo, float hi) { unsigned r; asm volatile("v_cvt_pk_bf16_f32 %0, %1, %2" : "=v"(r) : "v"(lo), "v"(hi)); return r; }
__device__ __forceinline__ float bf2f(unsigned short b) { return __uint_as_float(((unsigned)b) << 16); }
__device__ __forceinline__ float bflo(unsigned w) { return __uint_as_float(w << 16); }
__device__ __forceinline__ float bfhi(unsigned w) { return __uint_as_float(w & 0xffff0000u); }
__device__ __forceinline__ float wave_sum(float v) {
#pragma unroll
    for (int o = 1; o < 64; o <<= 1) v += __shfl_xor(v, o);
    return v;
}
__device__ __forceinline__ float sigmoidf_(float x) { return 1.0f / (1.0f + __expf(-x)); }
__device__ __forceinline__ float gelu_tanh(float x) { const float u = 0.7978845608028654f * (x + 0.044715f * x * x * x); return 0.5f * x * (1.0f + tanhf(u)); }

namespace pg8 {
constexpr int BM = 256, BK = 64, HALF = 128, HTB = HALF * BK * 2, STAGE_BYTES = 8 * HTB, NXCD = 8, WGM = 8;
__host__ __device__ __forceinline__ int lds_byte(int r, int c) { const int st = (r >> 4) * 2 + (c >> 5), rr = r & 15, cc = c & 31, ob = rr * 64 + cc * 2; return st * 1024 + (ob ^ (((ob >> 9) & 1) << 5)); }
__host__ __device__ __forceinline__ void stage_rc(int b, int& R, int& C) { const int st = b / 1024, sb = b % 1024, swz = sb ^ (((sb >> 9) & 1) << 5); R = (st >> 1) * 16 + swz / 64; C = (st & 1) * 32 + (swz % 64) / 2; }
__host__ __device__ __forceinline__ int perm32(int rho) { const int n = rho >> 4, i = rho & 15; return 8 * (i >> 2) + 4 * n + (i & 3); }

struct Unit { int pm, pn; };
struct Gemm { const bf16_t* A; const bf16_t* Bt; int M, N, K, lda, ldb; };

struct StaticOrder {
    int nM, nN, nwg, G, c, rep, wgm;
    __host__ __device__ void init(int M_, int N_, int G_, int c_, int rep_ = 1, int wgm_ = WGM) { nM = M_ / BM; nN = N_ / BM; nwg = nM * nN; G = G_; c = c_; rep = rep_; wgm = wgm_; }
    __host__ __device__ bool next(int i, Unit& u) const {
        long L = (long)i * G + c; if (c < 0 || L >= (long)nwg * rep) return false;
        if (L >= nwg) L -= nwg;
        int wgid = (int)L; { const int q = nwg / NXCD, r = nwg % NXCD, xcd = wgid % NXCD, off = wgid / NXCD; wgid = (xcd < r ? xcd * (q + 1) : r * (q + 1) + (xcd - r) * q) + off; }
        const int nig = wgm * nN, gid = wgid / nig, fm = gid * wgm, gsz = (nM - fm) < wgm ? (nM - fm) : wgm;
        u.pm = fm + ((wgid % nig) % gsz); u.pn = (wgid % nig) / gsz; return true;
    }
};

template <int ACT  > struct EpiBf16 {
    static constexpr bool PERM = true, MID = false;
    bf16_t* O; int ldc; const float* bias;
    __device__ __forceinline__ void operator()(const f32x4 (&acc)[2][2][4][2], const Unit& u, int wr, int wc, int fr, int fq) const {
        const int row0 = u.pm * BM + wr * 64 + fr; const int col0 = u.pn * BM + wc * 32 + 8 * fq;
        f32x4 bv[2][2];
#pragma unroll
        for (int bj = 0; bj < 2; ++bj)
#pragma unroll
            for (int n = 0; n < 2; ++n) bv[bj][n] = (ACT == 1) ? *(const f32x4*)(bias + col0 + bj * HALF + 4 * n) : (f32x4){0.f, 0.f, 0.f, 0.f};
#pragma unroll
        for (int ai = 0; ai < 2; ++ai)
#pragma unroll
            for (int m = 0; m < 4; ++m) { bf16_t* rowp = O + (size_t)(row0 + ai * HALF + m * 16) * ldc + col0;
#pragma unroll
                for (int bj = 0; bj < 2; ++bj) { f32x4 v0 = acc[ai][bj][m][0], v1 = acc[ai][bj][m][1];
                    if (ACT == 1) { v0 += bv[bj][0]; v1 += bv[bj][1];
#pragma unroll
                        for (int j = 0; j < 4; ++j) { v0[j] = sigmoidf_(v0[j]); v1[j] = sigmoidf_(v1[j]); } }
                    if (ACT == 2) {
#pragma unroll
                        for (int j = 0; j < 4; ++j) { const float a = fmaxf(v0[j], 0.f), b = fmaxf(v1[j], 0.f); v0[j] = a * a; v1[j] = b * b; } }
                    u32x4 w; w.x = cvt_pk_bf16(v0[0], v0[1]); w.y = cvt_pk_bf16(v0[2], v0[3]); w.z = cvt_pk_bf16(v1[0], v1[1]); w.w = cvt_pk_bf16(v1[2], v1[3]);
                    *(u32x4*)(rowp + bj * HALF) = w; } }
    }
};
struct EpiResF32 {
    static constexpr bool PERM = false, MID = false;
    float* out; const float* res; int ldc;
    __device__ __forceinline__ void operator()(const f32x4 (&acc)[2][2][4][2], const Unit& u, int wr, int wc, int fr, int fq) const {
        const int row0 = u.pm * BM + wr * 64 + fr, col0 = u.pn * BM + wc * 32 + 4 * fq;
#pragma unroll
        for (int ai = 0; ai < 2; ++ai)
#pragma unroll
            for (int m = 0; m < 4; ++m) { const size_t off = (size_t)(row0 + ai * HALF + m * 16) * ldc + col0;
#pragma unroll
                for (int bj = 0; bj < 2; ++bj)
#pragma unroll
                    for (int n = 0; n < 2; ++n) { const f32x4 r = *(const f32x4*)(res + off + bj * HALF + n * 16); *(f32x4*)(out + off + bj * HALF + n * 16) = acc[ai][bj][m][n] + r; } }
    }
};
struct EpiResNorm {
    static constexpr bool PERM = false, MID = false;
    float* out; const float* res; const float* gain; bf16_t* xg; float* ssq;
    __device__ __forceinline__ void operator()(const f32x4 (&acc)[2][2][4][2], const Unit& u, int wr, int wc, int fr, int fq) const {
        const int row0 = u.pm * BM + wr * 64 + fr, col0 = u.pn * BM + wc * 32 + 4 * fq;
        f32x4 gv[2][2];
#pragma unroll
        for (int bj = 0; bj < 2; ++bj)
#pragma unroll
            for (int n = 0; n < 2; ++n) gv[bj][n] = *(const f32x4*)(gain + col0 + bj * HALF + n * 16);
#pragma unroll
        for (int ai = 0; ai < 2; ++ai)
#pragma unroll
            for (int m = 0; m < 4; ++m) { const int row = row0 + ai * HALF + m * 16; const size_t off = (size_t)row * D + col0; float sq = 0.f;
#pragma unroll
                for (int bj = 0; bj < 2; ++bj)
#pragma unroll
                    for (int n = 0; n < 2; ++n) { const f32x4 r = *(const f32x4*)(res + off + bj * HALF + n * 16); const f32x4 v = acc[ai][bj][m][n] + r;
                        *(f32x4*)(out + off + bj * HALF + n * 16) = v; sq += (v[0] * v[0] + v[1] * v[1]) + (v[2] * v[2] + v[3] * v[3]);
                        const f32x4 g = gv[bj][n]; u32x2 w; w.x = cvt_pk_bf16(v[0] * g[0], v[1] * g[1]); w.y = cvt_pk_bf16(v[2] * g[2], v[3] * g[3]);
                        *(u32x2*)(xg + off + bj * HALF + n * 16) = w; }
                sq += __shfl_xor(sq, 16); sq += __shfl_xor(sq, 32);
                if (fq == 0) atomicAdd(ssq + row, sq); }
    }
};
struct EpiRelu2Norm {
    static constexpr bool PERM = true, MID = false;
    bf16_t* O; int ldc; const float* ssq;
    __device__ __forceinline__ void operator()(const f32x4 (&acc)[2][2][4][2], const Unit& u, int wr, int wc, int fr, int fq) const {
        const int row0 = u.pm * BM + wr * 64 + fr; const int col0 = u.pn * BM + wc * 32 + 8 * fq;
#pragma unroll
        for (int ai = 0; ai < 2; ++ai)
#pragma unroll
            for (int m = 0; m < 4; ++m) { const int row = row0 + ai * HALF + m * 16; bf16_t* rowp = O + (size_t)row * ldc + col0;
                const float r2 = __builtin_amdgcn_rcpf(ssq[row] * (1.0f / D) + EPS);
#pragma unroll
                for (int bj = 0; bj < 2; ++bj) { f32x4 v0 = acc[ai][bj][m][0], v1 = acc[ai][bj][m][1];
#pragma unroll
                    for (int j = 0; j < 4; ++j) { const float a = fmaxf(v0[j], 0.f), b = fmaxf(v1[j], 0.f); v0[j] = a * a * r2; v1[j] = b * b * r2; }
                    u32x4 w; w.x = cvt_pk_bf16(v0[0], v0[1]); w.y = cvt_pk_bf16(v0[2], v0[3]); w.z = cvt_pk_bf16(v1[0], v1[1]); w.w = cvt_pk_bf16(v1[2], v1[3]);
                    *(u32x4*)(rowp + bj * HALF) = w; } }
    }
};
constexpr int GP8 = 17408;
__device__ __forceinline__ float ub0(unsigned w) { return (float)(w & 0xffu); }
__device__ __forceinline__ float ub1(unsigned w) { return (float)((w >> 8) & 0xffu); }
__device__ __forceinline__ float ub2(unsigned w) { return (float)((w >> 16) & 0xffu); }
__device__ __forceinline__ float ub3(unsigned w) { return (float)(w >> 24); }
struct EpiGate8 {
    static constexpr bool PERM = true, MID = false;
    unsigned char* O; const float* bias;
    __device__ __forceinline__ void operator()(const f32x4 (&acc)[2][2][4][2], const Unit& u, int wr, int wc, int fr, int fq) const {
        const int row0 = u.pm * BM + wr * 64 + fr; const int col0 = u.pn * BM + wc * 32 + 8 * fq;
        f32x4 bv[2][2];
#pragma unroll
        for (int bj = 0; bj < 2; ++bj)
#pragma unroll
            for (int n = 0; n < 2; ++n) bv[bj][n] = *(const f32x4*)(bias + col0 + bj * HALF + 4 * n);
#pragma unroll
        for (int ai = 0; ai < 2; ++ai)
#pragma unroll
            for (int m = 0; m < 4; ++m) { unsigned char* rowp = O + (size_t)(row0 + ai * HALF + m * 16) * GP8 + col0;
#pragma unroll
                for (int bj = 0; bj < 2; ++bj) { const f32x4 v0 = acc[ai][bj][m][0] + bv[bj][0], v1 = acc[ai][bj][m][1] + bv[bj][1];
                    unsigned q[8];
#pragma unroll
                    for (int j = 0; j < 4; ++j) { q[j] = (unsigned)fmaxf(__builtin_rintf(sigmoidf_(v0[j]) * 255.f), 1.f); q[4 + j] = (unsigned)fmaxf(__builtin_rintf(sigmoidf_(v1[j]) * 255.f), 1.f); }
                    u32x2 w; w.x = q[0] | (q[1] << 8) | (q[2] << 16) | (q[3] << 24); w.y = q[4] | (q[5] << 8) | (q[6] << 16) | (q[7] << 24);
                    *(u32x2*)(rowp + bj * HALF) = w; } }
    }
};
struct EpiMix {
    static constexpr bool PERM = true, MID = true;
    bf16_t* O; const unsigned char* gates;
    __device__ __forceinline__ bool is_mid(int t) const { return t == 8 || t == 32; }
    __device__ __forceinline__ void mid(f32x4 (&acc)[2][2][4][2], const Unit& u, int wr, int wc, int fr, int fq, int t) const {
        const int offx = (t == 8) ? 0 : 2048;
        const unsigned char* gp0 = gates + (size_t)(u.pm * BM + wr * 64 + fr) * GP8 + u.pn * BM + wc * 32 + 8 * fq + offx;
#pragma unroll
        for (int ai = 0; ai < 2; ++ai) {
            u32x2 gx[4][2], gy[4][2];
#pragma unroll
            for (int m = 0; m < 4; ++m)
#pragma unroll
                for (int bj = 0; bj < 2; ++bj) { const unsigned char* gp = gp0 + (size_t)(ai * HALF + m * 16) * GP8 + bj * HALF; gx[m][bj] = *(const u32x2*)gp; gy[m][bj] = *(const u32x2*)(gp + 2048); }
#pragma unroll
            for (int m = 0; m < 4; ++m)
#pragma unroll
                for (int bj = 0; bj < 2; ++bj) { const u32x2 x = gx[m][bj], y = gy[m][bj];
                    f32x4 r0, r1;
                    r0[0] = __fdividef(ub0(x.x), ub0(y.x)); r0[1] = __fdividef(ub1(x.x), ub1(y.x)); r0[2] = __fdividef(ub2(x.x), ub2(y.x)); r0[3] = __fdividef(ub3(x.x), ub3(y.x));
                    r1[0] = __fdividef(ub0(x.y), ub0(y.y)); r1[1] = __fdividef(ub1(x.y), ub1(y.y)); r1[2] = __fdividef(ub2(x.y), ub2(y.y)); r1[3] = __fdividef(ub3(x.y), ub3(y.y));
                    acc[ai][bj][m][0] *= r0; acc[ai][bj][m][1] *= r1; }
            asm volatile("" ::: "memory"); }
    }
    __device__ __forceinline__ void operator()(const f32x4 (&acc)[2][2][4][2], const Unit& u, int wr, int wc, int fr, int fq) const {
        const int row0 = u.pm * BM + wr * 64 + fr; const int col0 = u.pn * BM + wc * 32 + 8 * fq; const float k = 1.0f / 255.0f;
#pragma unroll
        for (int ai = 0; ai < 2; ++ai)
#pragma unroll
            for (int m = 0; m < 4; ++m) { const size_t row = (size_t)(row0 + ai * HALF + m * 16);
#pragma unroll
                for (int bj = 0; bj < 2; ++bj) { const u32x2 g = *(const u32x2*)(gates + row * GP8 + 4096 + col0 + bj * HALF);
                    const f32x4 v0 = acc[ai][bj][m][0] * k, v1 = acc[ai][bj][m][1] * k;
                    u32x4 w; w.x = cvt_pk_bf16(v0[0] * ub0(g.x), v0[1] * ub1(g.x)); w.y = cvt_pk_bf16(v0[2] * ub2(g.x), v0[3] * ub3(g.x));
                    w.z = cvt_pk_bf16(v1[0] * ub0(g.y), v1[1] * ub1(g.y)); w.w = cvt_pk_bf16(v1[2] * ub2(g.y), v1[3] * ub3(g.y));
                    *(u32x4*)(O + row * D + col0 + bj * HALF) = w; } }
    }
};

template <class Epi, class Sched, bool ALIGN_EPI = true>
__device__ __forceinline__ void gemm_phase(LAS unsigned char* lds, const Gemm g, const Sched& S, const Epi& E) {
    const int tid = threadIdx.x, wid = __builtin_amdgcn_readfirstlane(tid >> 6), lane = tid & 63, wr = wid >> 2, wc = wid & 3, fr = lane & 15, fq = lane >> 4;
    const int K = g.K, nt = K / BK;
    unsigned voffA[2], voffB[2];
#pragma unroll
    for (int i = 0; i < 2; ++i) { int R, C; stage_rc(tid * 16 + i * 8192, R, C); const int Rb = Epi::PERM ? ((R & ~31) + perm32(R & 31)) : R;
        voffA[i] = (unsigned)(R * g.lda + C) * 2u; voffB[i] = (unsigned)(Rb * g.ldb + C) * 2u; }
    const size_t kstep = (size_t)(BK * 2);
    const size_t hstepA = (size_t)HALF * g.lda * 2, hstepB = (size_t)HALF * g.ldb * 2;
    const size_t tstepA = 2 * hstepA, tstepB = 2 * hstepB;
    const unsigned ldsw = (unsigned)wid * 1024u;
    const int aoff = lds_byte(wr * 64 + fr, fq * 8), boff = lds_byte(wc * 32 + fr, fq * 8);
#define PG8_SA(b, h) (((b) * 2 + (h)) * HTB)
#define PG8_SB(b, h) ((4 + (b) * 2 + (h)) * HTB)
#define PG8_STAGE(bufoff, gbase, voff) do { _Pragma("unroll") for (int _i = 0; _i < 2; ++_i) \
        __builtin_amdgcn_global_load_lds((const unsigned*)((const char*)(gbase) + (voff)[_i]), (LAS unsigned*)(lds + (bufoff) + ldsw + _i * 8192), 16, 0, 0); } while (0)
#define PG8_LDA(dst, b, h) do { _Pragma("unroll") for (int m = 0; m < 4; ++m) _Pragma("unroll") for (int k = 0; k < 2; ++k) dst[m][k] = *(const LAS bf16x8*)(lds + PG8_SA(b, h) + aoff + m * 2048 + k * 1024); } while (0)
#define PG8_LDB(dst, b, h) do { _Pragma("unroll") for (int n = 0; n < 2; ++n) _Pragma("unroll") for (int k = 0; k < 2; ++k) dst[n][k] = *(const LAS bf16x8*)(lds + PG8_SB(b, h) + boff + n * 2048 + k * 1024); } while (0)
#define PG8_MMA(ai, bj, At, Bt) do { __builtin_amdgcn_s_setprio(1); _Pragma("unroll") for (int m = 0; m < 4; ++m) _Pragma("unroll") for (int n = 0; n < 2; ++n) _Pragma("unroll") for (int k = 0; k < 2; ++k) \
        acc[ai][bj][m][n] = __builtin_amdgcn_mfma_f32_16x16x32_bf16(Bt[n][k], At[m][k], acc[ai][bj][m][n], 0, 0, 0); __builtin_amdgcn_s_setprio(0); } while (0)
#define PG8_WAIT_V(n) asm volatile("s_waitcnt vmcnt(" #n ")" ::: "memory")
#define PG8_WAIT_L(n) asm volatile("s_waitcnt lgkmcnt(" #n ")" ::: "memory")
#define PG8_BAR __builtin_amdgcn_s_barrier()
#define PG8_SCHED __builtin_amdgcn_sched_barrier(0)
    Unit cur, nxt; int ui = 0;
    if (!S.next(0, cur)) return;
    f32x4 acc[2][2][4][2];
#pragma unroll
    for (int a = 0; a < 2; ++a)
#pragma unroll
        for (int b = 0; b < 2; ++b)
#pragma unroll
            for (int m = 0; m < 4; ++m)
#pragma unroll
                for (int n = 0; n < 2; ++n) acc[a][b][m][n] = (f32x4){0.f, 0.f, 0.f, 0.f};
    bf16x8 At[4][2], B0[2][2], B1[2][2];
    const char* cA = (const char*)g.A + (size_t)cur.pm * tstepA; const char* cB = (const char*)g.Bt + (size_t)cur.pn * tstepB;
    PG8_STAGE(PG8_SB(0, 0), cB, voffB); PG8_STAGE(PG8_SB(0, 1), cB + hstepB, voffB); PG8_STAGE(PG8_SA(0, 0), cA, voffA); PG8_STAGE(PG8_SA(0, 1), cA + hstepA, voffA);
    if (wr == 1) PG8_BAR;
    PG8_WAIT_V(2); PG8_BAR;
    PG8_STAGE(PG8_SB(1, 0), cB + kstep, voffB); PG8_STAGE(PG8_SA(1, 0), cA + kstep, voffA); PG8_STAGE(PG8_SB(1, 1), cB + hstepB + kstep, voffB);
    PG8_WAIT_V(6); PG8_BAR;
    for (;;) {
        const bool has_next = S.next(ui + 1, nxt);
        const char* nA = has_next ? (const char*)g.A + (size_t)nxt.pm * tstepA : cA; const char* nB = has_next ? (const char*)g.Bt + (size_t)nxt.pn * tstepB : cB;
        for (int t = 0; t < nt; t += 2) {
            const bool last = (t == nt - 2);
            const char* a1 = cA + (size_t)(t + 1) * kstep;
            const char* a2 = last ? nA : cA + (size_t)(t + 2) * kstep; const char* b2 = last ? nB : cB + (size_t)(t + 2) * kstep;
            const char* a3 = a2 + kstep; const char* b3 = b2 + kstep;
            PG8_LDB(B0, 0, 0); PG8_LDB(B1, 0, 1); PG8_SCHED; PG8_LDA(At, 0, 0); PG8_STAGE(PG8_SA(1, 1), a1 + hstepA, voffA);
            PG8_WAIT_V(8); PG8_WAIT_L(0); PG8_BAR; PG8_MMA(0, 0, At, B0); PG8_MMA(0, 1, At, B1); PG8_BAR; PG8_SCHED;
            PG8_LDA(At, 0, 1); PG8_STAGE(PG8_SB(0, 0), b2, voffB); PG8_STAGE(PG8_SB(0, 1), b2 + hstepB, voffB); PG8_STAGE(PG8_SA(0, 0), a2, voffA);
            PG8_WAIT_V(8); PG8_WAIT_L(0); PG8_BAR; PG8_MMA(1, 0, At, B0); PG8_MMA(1, 1, At, B1); PG8_BAR; PG8_SCHED;
            PG8_LDB(B0, 1, 0); PG8_LDB(B1, 1, 1); PG8_SCHED; PG8_LDA(At, 1, 0); PG8_STAGE(PG8_SA(0, 1), a2 + hstepA, voffA);
            PG8_WAIT_V(8); PG8_WAIT_L(0); PG8_BAR; PG8_MMA(0, 0, At, B0); PG8_MMA(0, 1, At, B1); PG8_BAR; PG8_SCHED;
            PG8_LDA(At, 1, 1); PG8_STAGE(PG8_SB(1, 0), b3, voffB); PG8_STAGE(PG8_SB(1, 1), b3 + hstepB, voffB); PG8_STAGE(PG8_SA(1, 0), a3, voffA);
            PG8_WAIT_V(8); PG8_WAIT_L(0); PG8_BAR; PG8_MMA(1, 0, At, B0); PG8_MMA(1, 1, At, B1); PG8_BAR; PG8_SCHED;
            if constexpr (Epi::MID) { if (E.is_mid(t + 2)) { E.mid(acc, cur, wr, wc, fr, fq, t + 2); PG8_SCHED; } }
        }
        if constexpr (ALIGN_EPI) { if (wr == 0) PG8_BAR; }
        E(acc, cur, wr, wc, fr, fq);
        if (!has_next) break;
#pragma unroll
        for (int a = 0; a < 2; ++a)
#pragma unroll
            for (int b = 0; b < 2; ++b)
#pragma unroll
                for (int m = 0; m < 4; ++m)
#pragma unroll
                    for (int n = 0; n < 2; ++n) acc[a][b][m][n] = (f32x4){0.f, 0.f, 0.f, 0.f};
        cur = nxt; cA = nA; cB = nB; ++ui;
        if constexpr (ALIGN_EPI) { if (wr == 1) PG8_BAR; }
    }
    PG8_WAIT_V(0);
    if constexpr (!ALIGN_EPI) { if (wr == 0) PG8_BAR; }
    PG8_BAR;
#undef PG8_SA
#undef PG8_SB
#undef PG8_STAGE
#undef PG8_LDA
#undef PG8_LDB
#undef PG8_MMA
#undef PG8_WAIT_V
#undef PG8_WAIT_L
#undef PG8_BAR
#undef PG8_SCHED
}
}

struct Args {
    const float *x, *mem, *rel_bias, *norm_mix, *norm_mem, *norm_mlp, *norm_final, *w_in, *w_gate, *b_gate, *conv_w, *conv_b,
                *lru_wa, *lru_ba, *lru_wi, *lru_bi, *lru_lambda, *w_mem_kv, *w_o_attn, *w_o_lru, *w_o_mem, *w_out, *w_up, *w_down;
    float* out; unsigned char* ws; int ph_lo, ph_hi;
};

struct Frame { LAS unsigned char* lds; int tid, lane, wave, G, bid; };

__device__ __forceinline__ void p0_transpose_item(const float* W, int N, bf16_t* WT, int ldt, int coff, LAS float* scr, int item, int lane) {
    const int nblk = N / 32, kb = item / nblk, nb = item % nblk, k0 = 64 * kb, n0 = 32 * nb;
    { f32x4 v[8];
#pragma unroll
      for (int i = 0; i < 8; ++i) v[i] = __builtin_nontemporal_load((const f32x4*)(W + (size_t)(k0 + 8 * i + (lane >> 3)) * N + n0 + 4 * (lane & 7)));
#pragma unroll
      for (int i = 0; i < 8; ++i) { LAS float* d = scr + (8 * i + (lane >> 3)) * 33 + 4 * (lane & 7); d[0] = v[i].x; d[1] = v[i].y; d[2] = v[i].z; d[3] = v[i].w; } }
    asm volatile("s_waitcnt lgkmcnt(0)" ::: "memory");
    const int c = lane & 7;
#pragma unroll
    for (int j = 0; j < 4; ++j) { const int n = (lane >> 3) + 8 * j; const LAS float* s = scr + (8 * c) * 33 + n;
        u32x4 o; o.x = cvt_pk_bf16(s[0 * 33], s[1 * 33]); o.y = cvt_pk_bf16(s[2 * 33], s[3 * 33]); o.z = cvt_pk_bf16(s[4 * 33], s[5 * 33]); o.w = cvt_pk_bf16(s[6 * 33], s[7 * 33]);
        *(u32x4*)(WT + (size_t)(n0 + n) * ldt + coff + k0 + 8 * c) = o; }
    asm volatile("s_waitcnt lgkmcnt(0)" ::: "memory");
}
__device__ __forceinline__ void rms_row_bf16(const float* xrow, const float* gain, bf16_t* orow, int lane) {
    const f32x4* xr = (const f32x4*)xrow + lane; const f32x4* gr = (const f32x4*)gain + lane;
    f32x4 v[8]; float s = 0.f;
#pragma unroll
    for (int j = 0; j < 8; ++j) { v[j] = __builtin_nontemporal_load(xr + 64 * j); s += (v[j].x * v[j].x + v[j].y * v[j].y) + (v[j].z * v[j].z + v[j].w * v[j].w); }
    const float rs = rsqrtf(wave_sum(s) * (1.f / D) + EPS);
    u32x2* o8 = (u32x2*)orow + lane;
#pragma unroll
    for (int j = 0; j < 8; ++j) { const f32x4 g = gr[64 * j]; u32x2 w; w.x = cvt_pk_bf16(v[j].x * rs * g.x, v[j].y * rs * g.y); w.y = cvt_pk_bf16(v[j].z * rs * g.z, v[j].w * rs * g.w); o8[64 * j] = w; }
}
__device__ __forceinline__ void rms_row_f32(float* xrow, const float* gain, int lane) {
    f32x4* xr = (f32x4*)xrow + lane; const f32x4* gr = (const f32x4*)gain + lane;
    f32x4 v[8]; float s = 0.f;
#pragma unroll
    for (int j = 0; j < 8; ++j) { v[j] = __builtin_nontemporal_load(xr + 64 * j); s += (v[j].x * v[j].x + v[j].y * v[j].y) + (v[j].z * v[j].z + v[j].w * v[j].w); }
    const float rs = rsqrtf(wave_sum(s) * (1.f / D) + EPS);
#pragma unroll
    for (int j = 0; j < 8; ++j) { const f32x4 g = gr[64 * j]; xr[64 * j] = v[j] * rs * g; }
}

__device__ __forceinline__ void rms_row_add_bf16(const float* xrow, const bf16_t* mrow, const float* gain, bf16_t* orow, int lane) {
    const f32x4* xr = (const f32x4*)xrow + lane; const u32x2* mr = (const u32x2*)mrow + lane; const f32x4* gr = (const f32x4*)gain + lane;
    f32x4 v[8]; float s = 0.f;
#pragma unroll
    for (int j = 0; j < 8; ++j) { const u32x2 mm = mr[64 * j]; v[j] = __builtin_nontemporal_load(xr + 64 * j); v[j].x += bflo(mm.x); v[j].y += bfhi(mm.x); v[j].z += bflo(mm.y); v[j].w += bfhi(mm.y);
        s += (v[j].x * v[j].x + v[j].y * v[j].y) + (v[j].z * v[j].z + v[j].w * v[j].w); }
    const float rs = rsqrtf(wave_sum(s) * (1.f / D) + EPS);
    u32x2* o8 = (u32x2*)orow + lane;
#pragma unroll
    for (int j = 0; j < 8; ++j) { const f32x4 g = gr[64 * j]; u32x2 w; w.x = cvt_pk_bf16(v[j].x * rs * g.x, v[j].y * rs * g.y); w.y = cvt_pk_bf16(v[j].z * rs * g.z, v[j].w * rs * g.w); o8[64 * j] = w; }
}
__device__ __forceinline__ void rms_row_final(const float* xrow, const bf16_t* mrow, const bf16_t* drow, const float* gain, float* orow, int lane) {
    const f32x4* xr = (const f32x4*)xrow + lane; const u32x2* mr = (const u32x2*)mrow + lane; const u32x2* dr = (const u32x2*)drow + lane; const f32x4* gr = (const f32x4*)gain + lane;
    f32x4 v[8]; float s = 0.f;
#pragma unroll
    for (int j = 0; j < 8; ++j) { const u32x2 mm = mr[64 * j], dd = dr[64 * j]; v[j] = __builtin_nontemporal_load(xr + 64 * j);
        v[j].x += bflo(mm.x) + bflo(dd.x); v[j].y += bfhi(mm.x) + bfhi(dd.x); v[j].z += bflo(mm.y) + bflo(dd.y); v[j].w += bfhi(mm.y) + bfhi(dd.y);
        s += (v[j].x * v[j].x + v[j].y * v[j].y) + (v[j].z * v[j].z + v[j].w * v[j].w); }
    const float rs = rsqrtf(wave_sum(s) * (1.f / D) + EPS);
    f32x4* o = (f32x4*)orow + lane;
#pragma unroll
    for (int j = 0; j < 8; ++j) { const f32x4 g = gr[64 * j]; o[64 * j] = v[j] * rs * g; }
}

struct TrJob { const float* W; int K, N; bf16_t* WT; int ldt, coff; };

__device__ __forceinline__ void phase0(const Frame& F, const Args& a) {
    unsigned char* ws = a.ws;
    LAS float* scr = (LAS float*)(F.lds + F.wave * 16384);
    const int gw = F.bid * 8 + F.wave, NGW = F.G * 8;
    {
        int base = 0;
#define TR(Wp, K_, N_, WTp, ldt_, coff_) { const int ni = ((K_) / 64) * ((N_) / 32); int first = ((gw - base) % NGW + NGW) % NGW; \
            for (int it = first; it < ni; it += NGW) p0_transpose_item((Wp), (N_), (bf16_t*)(WTp), (ldt_), (coff_), scr, it, F.lane); base = (base + ni) % NGW; }
        TR(a.w_in, D, NIN, ws + WS_WIN, D, 0)
        TR(a.w_gate, D, NG, ws + WS_WGATE, D, 0)
        TR(a.w_mem_kv, D, 2048, ws + WS_WMKV, D, 0)
        TR(a.w_o_attn, 512, D, ws + WS_WO, YP, 0)
        TR(a.w_o_lru, 1536, D, ws + WS_WO, YP, 512)
        TR(a.w_o_mem, 1024, D, ws + WS_WO, YP, 2048)
        TR(a.w_out, D, D, ws + WS_WOUT, D, 0)
        TR(a.w_up, D, DFF, ws + WS_WUP, D, 0)
        TR(a.w_down, DFF, D, ws + WS_WDN, DFF, 0)
#undef TR
        for (int it = gw; it < 48 * 8; it += NGW) { const int mat = it >> 3, sub = it & 7; const int which = mat / 24, dn = mat % 24;
            const float* W = (which ? a.lru_wi : a.lru_wa) + (size_t)dn * 16384;
            p0_transpose_item(W, 128, (bf16_t*)(ws + WS_WLRU) + (size_t)(dn * 2 + which) * 16384, 128, 0, scr, sub, F.lane); }
    }
    for (int m = gw; m < M; m += NGW) rms_row_bf16(a.x + (size_t)m * D, a.norm_mix, (bf16_t*)(ws + WS_H) + (size_t)m * D, F.lane);
    for (int m = gw; m < BATCH * NMEM; m += NGW) rms_row_bf16(a.mem + (size_t)m * D, a.norm_mem, (bf16_t*)(ws + WS_MEMN) + (size_t)m * D, F.lane);
    if (F.bid == 1) { for (int i = F.tid; i < M; i += 512) ((float*)(ws + WS_SSQ))[i] = 0.f; }
    if (F.bid == 0) {
        for (int i = F.tid; i < 12 * 129; i += 512) { const int h = i / 129, rel = i % 129 - 64; const int g = h >> 2, d = (g == 0) ? 1 : (g == 1 ? 4 : 16);
            const int off = rel * d; const int n = off < 0 ? -off : off; int bucket = (off > 0) ? 16 : 0;
            if (n < 8) bucket += n; else { int large = 8 + (int)(log((double)n / 8.0) / log(128.0) * 8.0); if (large > 15) large = 15; bucket += large; }
            ((float*)(ws + WS_TAB))[h * 132 + rel + 64] = a.rel_bias[bucket * 12 + h]; }
    }
}

constexpr int AT_PITCH = 272, AT_R1 = 69632, AT_TAB = 139264;
__device__ __forceinline__ s16x4 vtr(const LAS char* p) { return __builtin_bit_cast(s16x4, __builtin_amdgcn_ds_read_tr16_b64_v4i16((LAS s16x4*)p)); }

template <int NCT>
__device__ __forceinline__ void qk_accum(f32x4 (&s)[NCT], const LAS unsigned char* Kt, int key_row0, const bf16x8 (&qf)[4], int fr, int fq) {
#pragma unroll
    for (int ct = 0; ct < NCT; ++ct)
#pragma unroll
        for (int ks = 0; ks < 4; ++ks) { const bf16x8 kf = *(const LAS bf16x8*)(Kt + (key_row0 + 16 * ct + fr) * AT_PITCH + 64 * ks + 16 * fq);
            s[ct] = __builtin_amdgcn_mfma_f32_16x16x32_bf16(kf, qf[ks], s[ct], 0, 0, 0); if (ks == 3 && (ct & 1)) asm volatile("" ::: "memory"); }
}
template <int NKS>
__device__ __forceinline__ void pv_accum(f32x4 (&o)[8], const LAS unsigned char* Vt, int key_row0, const bf16x8 (&pf)[NKS], int fr, int fq) {
#pragma unroll
    for (int ks = 0; ks < NKS; ++ks) {
        const LAS char* p0 = (const LAS char*)Vt + (key_row0 + 32 * ks + 4 * fq + (fr >> 2)) * AT_PITCH + 8 * (fr & 3);
#pragma unroll
        for (int dt = 0; dt < 8; ++dt) { const s16x4 lo = vtr(p0 + 32 * dt), hi = vtr(p0 + 16 * AT_PITCH + 32 * dt);
            const bf16x8 vf = {lo[0], lo[1], lo[2], lo[3], hi[0], hi[1], hi[2], hi[3]};
            o[dt] = __builtin_amdgcn_mfma_f32_16x16x32_bf16(vf, pf[ks], o[dt], 0, 0, 0); }
        asm volatile("" ::: "memory");
    }
}
#define STAGE_TILE(REG, ROWPTR_EXPR) do { _Pragma("unroll") for (int _it = 0; _it < 8; ++_it) { const int _idx = F.tid + 512 * _it; const int i = _idx >> 4, _ch = _idx & 15; \
        const bf16_t* _rp = (ROWPTR_EXPR); u32x4 _v = (u32x4){0u, 0u, 0u, 0u}; if (_rp) _v = *(const u32x4*)(_rp + 8 * _ch); *(LAS u32x4*)((REG) + i * AT_PITCH + 16 * _ch) = _v; } } while (0)

#define STAGE_TILE2(REGA, ROWPTR_A, REGB, ROWPTR_B) do { u32x4 _va[8], _vb[8]; \
        _Pragma("unroll") for (int _it = 0; _it < 8; ++_it) { const int _idx = F.tid + 512 * _it; const int i = _idx >> 4, _ch = _idx & 15; \
            const bf16_t* _rpa = (ROWPTR_A); const bf16_t* _rpb = (ROWPTR_B); _va[_it] = (u32x4){0u, 0u, 0u, 0u}; _vb[_it] = (u32x4){0u, 0u, 0u, 0u}; \
            if (_rpa) _va[_it] = *(const u32x4*)(_rpa + 8 * _ch); if (_rpb) _vb[_it] = *(const u32x4*)(_rpb + 8 * _ch); } \
        _Pragma("unroll") for (int _it = 0; _it < 8; ++_it) { const int _idx = F.tid + 512 * _it; const int i = _idx >> 4, _ch = _idx & 15; \
            *(LAS u32x4*)((REGA) + i * AT_PITCH + 16 * _ch) = _va[_it]; *(LAS u32x4*)((REGB) + i * AT_PITCH + 16 * _ch) = _vb[_it]; } } while (0)

__device__ __forceinline__ void attnA_item(const Frame& F, const Args& a, int item) {
    const bf16_t* proj = (const bf16_t*)(a.ws + WS_PROJ);
    const int b = item / 384, rem = item % 384, h = rem >> 5, q = rem & 31, g = h >> 2, hh = h & 3;
    const int dsh = 2 * g, d = 1 << dsh, L = SEQ >> dsh, npairs = 32 >> dsh, r = q / npairs, n0 = 2 * (q % npairs);
    const int fr = F.lane & 15, fq = F.lane >> 4, hb = F.wave >> 2;
    const size_t rowbase = (size_t)b * SEQ;
    const int kp0 = (n0 - 1) * 64;
    LAS unsigned char* R0 = F.lds; LAS unsigned char* R1 = F.lds + AT_R1; LAS float* tab = (LAS float*)(F.lds + AT_TAB);
    __syncthreads();
    STAGE_TILE2(R0, ((kp0 + i >= 0 && kp0 + i < L) ? proj + (rowbase + (size_t)(kp0 + i) * d + r) * NIN + C_K + h * 128 : (const bf16_t*)nullptr),
                R1, ((kp0 + i >= 0 && kp0 + i < L) ? proj + (rowbase + (size_t)(kp0 + i) * d + r) * NIN + C_V + h * 128 : (const bf16_t*)nullptr));
    if (F.tid < 129) tab[F.tid] = ((const float*)(a.ws + WS_TAB))[h * 132 + F.tid];
    const int qq = 16 * (F.wave & 3) + fr;
    const int qpos = (n0 + hb) * 64 + qq;
    const size_t qrow = rowbase + (size_t)qpos * d + r;
    bf16x8 qf[4];
#pragma unroll
    for (int ks = 0; ks < 4; ++ks) qf[ks] = *(const bf16x8*)(proj + qrow * NIN + C_Q + h * 128 + 32 * ks + 8 * fq);
    __syncthreads();
    f32x4 s[12];
#pragma unroll
    for (int ct = 0; ct < 12; ++ct) s[ct] = (f32x4){0.f, 0.f, 0.f, 0.f};
    qk_accum<12>(s, R0, 64 * hb, qf, fr, fq);
    const float scale = 0.08838834764831845f;
    const int kpw = (n0 + hb - 1) * 64;
    float mx = -3.0e38f;
#pragma unroll
    for (int ct = 0; ct < 12; ++ct)
#pragma unroll
        for (int j = 0; j < 4; ++j) { const int kk = 16 * ct + 4 * fq + j; const int rel = kk - 64 - qq; const int kp = kpw + kk;
            const bool valid = (rel >= -64) && (rel <= 64) && (kp >= 0) && (kp < L);
            const float bias = tab[valid ? rel + 64 : 64];
            const float l = valid ? s[ct][j] * scale + bias : -1e30f; s[ct][j] = l; mx = fmaxf(mx, l); }
    mx = fmaxf(mx, __shfl_xor(mx, 16)); mx = fmaxf(mx, __shfl_xor(mx, 32));
    float sum = 0.f;
#pragma unroll
    for (int ct = 0; ct < 12; ++ct)
#pragma unroll
        for (int j = 0; j < 4; ++j) { const float p = __expf(s[ct][j] - mx); s[ct][j] = p; sum += p; }
    sum += __shfl_xor(sum, 16); sum += __shfl_xor(sum, 32);
    bf16x8 pf[6];
#pragma unroll
    for (int ks = 0; ks < 6; ++ks) { u32x4 w; w.x = cvt_pk_bf16(s[2 * ks][0], s[2 * ks][1]); w.y = cvt_pk_bf16(s[2 * ks][2], s[2 * ks][3]);
        w.z = cvt_pk_bf16(s[2 * ks + 1][0], s[2 * ks + 1][1]); w.w = cvt_pk_bf16(s[2 * ks + 1][2], s[2 * ks + 1][3]); pf[ks] = __builtin_bit_cast(bf16x8, w); }
    f32x4 o[8];
#pragma unroll
    for (int dt = 0; dt < 8; ++dt) o[dt] = (f32x4){0.f, 0.f, 0.f, 0.f};
    pv_accum<6>(o, R1, 64 * hb, pf, fr, fq);
    const float inv = 1.0f / sum;
    bf16_t* orow = (g == 0) ? (bf16_t*)a.out + qrow * YP + hh * 128 : (bf16_t*)((unsigned char*)a.out + DO_O12) + qrow * 1024 + (g - 1) * 512 + hh * 128;
#pragma unroll
    for (int dt = 0; dt < 8; ++dt) { u32x2 w; w.x = cvt_pk_bf16(o[dt][0] * inv, o[dt][1] * inv); w.y = cvt_pk_bf16(o[dt][2] * inv, o[dt][3] * inv); *(u32x2*)(orow + 16 * dt + 4 * fq) = w; }
    if (fq == 0) ((float*)(a.ws + WS_LSE))[qrow * 12 + h] = mx + __logf(sum);
}

__device__ __forceinline__ void attnC_item(const Frame& F, const Args& a, int item) {
    const bf16_t* proj = (const bf16_t*)(a.ws + WS_PROJ); const bf16_t* kv = (const bf16_t*)(a.ws + WS_KV);
    const int b = item >> 7, head = (item >> 5) & 3, qb = item & 31;
    const int fr = F.lane & 15, fq = F.lane >> 4;
    LAS unsigned char* R0 = F.lds; LAS unsigned char* R1 = F.lds + AT_R1;
    const size_t qrow = (size_t)b * SEQ + qb * 128 + 16 * F.wave + fr;
    const bf16_t* kbase = kv + (size_t)b * NMEM * 2048 + head * 256;
    __syncthreads();
    STAGE_TILE2(R0, (kbase + (size_t)i * 2048), R1, (kbase + (size_t)i * 2048 + 128));
    bf16x8 qf[4];
    f32x4 s[16];
#pragma unroll
    for (int ct = 0; ct < 16; ++ct) s[ct] = (f32x4){0.f, 0.f, 0.f, 0.f};
#pragma unroll
    for (int ks = 0; ks < 4; ++ks) qf[ks] = *(const bf16x8*)(proj + qrow * NIN + C_QC + head * 256 + 32 * ks + 8 * fq);
    __syncthreads();
    qk_accum<16>(s, R0, 0, qf, fr, fq);
#pragma unroll
    for (int ks = 0; ks < 4; ++ks) qf[ks] = *(const bf16x8*)(proj + qrow * NIN + C_QC + head * 256 + 128 + 32 * ks + 8 * fq);
    qk_accum<16>(s, R1, 0, qf, fr, fq);
    float mx = -3.0e38f;
#pragma unroll
    for (int ct = 0; ct < 16; ++ct)
#pragma unroll
        for (int j = 0; j < 4; ++j) { const float l = s[ct][j] * 0.0625f; s[ct][j] = l; mx = fmaxf(mx, l); }
    mx = fmaxf(mx, __shfl_xor(mx, 16)); mx = fmaxf(mx, __shfl_xor(mx, 32));
    float sum = 0.f;
#pragma unroll
    for (int ct = 0; ct < 16; ++ct)
#pragma unroll
        for (int j = 0; j < 4; ++j) { const float p = __expf(s[ct][j] - mx); s[ct][j] = p; sum += p; }
    sum += __shfl_xor(sum, 16); sum += __shfl_xor(sum, 32);
    bf16x8 pf[8];
#pragma unroll
    for (int ks = 0; ks < 8; ++ks) { u32x4 w; w.x = cvt_pk_bf16(s[2 * ks][0], s[2 * ks][1]); w.y = cvt_pk_bf16(s[2 * ks][2], s[2 * ks][3]);
        w.z = cvt_pk_bf16(s[2 * ks + 1][0], s[2 * ks + 1][1]); w.w = cvt_pk_bf16(s[2 * ks + 1][2], s[2 * ks + 1][3]); pf[ks] = __builtin_bit_cast(bf16x8, w); }
    __syncthreads();
    STAGE_TILE2(R0, (kbase + (size_t)i * 2048 + 1024), R1, (kbase + (size_t)i * 2048 + 1024 + 128));
    __syncthreads();
    const float inv = 1.0f / sum;
    bf16_t* orow = (bf16_t*)a.out + qrow * YP + 2048 + head * 256;
#pragma unroll
    for (int half = 0; half < 2; ++half) {
        f32x4 o[8];
#pragma unroll
        for (int dt = 0; dt < 8; ++dt) o[dt] = (f32x4){0.f, 0.f, 0.f, 0.f};
        pv_accum<8>(o, half ? R1 : R0, 0, pf, fr, fq);
#pragma unroll
        for (int dt = 0; dt < 8; ++dt) { u32x2 w; w.x = cvt_pk_bf16(o[dt][0] * inv, o[dt][1] * inv); w.y = cvt_pk_bf16(o[dt][2] * inv, o[dt][3] * inv); *(u32x2*)(orow + 128 * half + 16 * dt + 4 * fq) = w; }
    }
}

__device__ __forceinline__ void combine_row(const Args& a, size_t row, int lane) {
    bf16_t* y = (bf16_t*)a.out + row * YP + 8 * lane; const bf16_t* o12 = (const bf16_t*)((unsigned char*)a.out + DO_O12) + row * 1024 + 8 * lane;
    const float* lse = (const float*)(a.ws + WS_LSE) + row * 12; const int hh = lane >> 4;
    const float l0 = lse[hh], l1 = lse[4 + hh], l2 = lse[8 + hh]; const float mx = fmaxf(l0, fmaxf(l1, l2));
    float w0 = __expf(l0 - mx), w1 = __expf(l1 - mx), w2 = __expf(l2 - mx); const float inv = 1.0f / (w0 + w1 + w2); w0 *= inv; w1 *= inv; w2 *= inv;
    const u32x4 v0 = *(const u32x4*)y, v1 = *(const u32x4*)o12, v2 = *(const u32x4*)(o12 + 512);
    u32x4 w;
    w.x = cvt_pk_bf16(w0 * bflo(v0.x) + w1 * bflo(v1.x) + w2 * bflo(v2.x), w0 * bfhi(v0.x) + w1 * bfhi(v1.x) + w2 * bfhi(v2.x));
    w.y = cvt_pk_bf16(w0 * bflo(v0.y) + w1 * bflo(v1.y) + w2 * bflo(v2.y), w0 * bfhi(v0.y) + w1 * bfhi(v1.y) + w2 * bfhi(v2.y));
    w.z = cvt_pk_bf16(w0 * bflo(v0.z) + w1 * bflo(v1.z) + w2 * bflo(v2.z), w0 * bfhi(v0.z) + w1 * bfhi(v1.z) + w2 * bfhi(v2.z));
    w.w = cvt_pk_bf16(w0 * bflo(v0.w) + w1 * bflo(v1.w) + w2 * bflo(v2.w), w0 * bfhi(v0.w) + w1 * bfhi(v1.w) + w2 * bfhi(v2.w));
    *(u32x4*)y = w;
}

constexpr int LR_AT = 70656;
__device__ __forceinline__ int lru_perm(int t) { return (t & ~63) | ((t & 12) << 2) | ((t & 48) >> 2) | (t & 3); }
__device__ __forceinline__ float fsig(float x) { return __builtin_amdgcn_rcpf(1.0f + __expf(-x)); }
template <bool PASS2>
__device__ __forceinline__ void lru_item(const Frame& F, const Args& a, int item) {
    const bf16_t* proj = (const bf16_t*)(a.ws + WS_PROJ);
    const int n = item % 12, chunk = (item / 12) % NCHUNK, b = item / (12 * NCHUNK);
    const int t0 = chunk * CHUNK; const size_t rowbase = (size_t)b * SEQ;
    const int fr = F.lane & 15, fq = F.lane >> 4, w = F.wave;
    const int c = 16 * w + fr, cg_ = n * 128 + c;
    const int cch = F.tid & 15, r0 = F.tid >> 4;
    LAS unsigned char* R0 = F.lds; LAS unsigned char* AT = F.lds + LR_AT;
    __syncthreads();
    for (int idx = F.tid; idx < 259 * 16; idx += 512) { const int row = idx >> 4, ch = idx & 15; const int t = t0 - 1 + row; u32x4 v = (u32x4){0u, 0u, 0u, 0u};
        if (t >= 0 && t < SEQ) v = *(const u32x4*)(proj + (rowbase + t) * NIN + C_XB + n * 128 + 8 * ch);
        *(LAS u32x4*)(R0 + row * AT_PITCH + 16 * ch) = v; }
    {
        f32x4 cw[4][2], cbv[2];
#pragma unroll
        for (int j = 0; j < 4; ++j) { cw[j][0] = *(const f32x4*)(a.conv_w + j * 1536 + n * 128 + 8 * cch); cw[j][1] = *(const f32x4*)(a.conv_w + j * 1536 + n * 128 + 8 * cch + 4); }
        cbv[0] = *(const f32x4*)(a.conv_b + n * 128 + 8 * cch); cbv[1] = *(const f32x4*)(a.conv_b + n * 128 + 8 * cch + 4);
        u32x4 ybv[8];
        if (PASS2) {
#pragma unroll
            for (int it = 0; it < 8; ++it) ybv[it] = *(const u32x4*)(proj + (rowbase + t0 + r0 + 32 * it) * NIN + C_YB + n * 128 + 8 * cch);
        }
        __syncthreads();
#pragma unroll 2
        for (int it = 0; it < 8; ++it) { const int tl = r0 + 32 * it;
            f32x4 x0 = cbv[0], x1 = cbv[1];
#pragma unroll
            for (int j = 0; j < 4; ++j) { const u32x4 v = *(const LAS u32x4*)(R0 + (tl + j) * AT_PITCH + 16 * cch);
                x0[0] += cw[j][0][0] * bflo(v.x); x0[1] += cw[j][0][1] * bfhi(v.x); x0[2] += cw[j][0][2] * bflo(v.y); x0[3] += cw[j][0][3] * bfhi(v.y);
                x1[0] += cw[j][1][0] * bflo(v.z); x1[1] += cw[j][1][1] * bfhi(v.z); x1[2] += cw[j][1][2] * bflo(v.w); x1[3] += cw[j][1][3] * bfhi(v.w); }
            u32x4 o; o.x = cvt_pk_bf16(x0[0], x0[1]); o.y = cvt_pk_bf16(x0[2], x0[3]); o.z = cvt_pk_bf16(x1[0], x1[1]); o.w = cvt_pk_bf16(x1[2], x1[3]);
            *(LAS u32x4*)(AT + lru_perm(tl) * AT_PITCH + 16 * cch) = o; }
        __syncthreads();
        if (PASS2) {
#pragma unroll
            for (int it = 0; it < 8; ++it) *(LAS u32x4*)(R0 + (r0 + 32 * it) * AT_PITCH + 16 * cch) = ybv[it];
        }
    }
    bf16x8 sel;
    { const bool mine = (fq == 2 * (w & 1) + (fr >> 3));
#pragma unroll
      for (int jj = 0; jj < 8; ++jj) sel[jj] = (mine && jj == (fr & 7)) ? (short)0x3F80 : (short)0; }
    const int ks0 = w >> 1;
    float hf[4][4][4];
#pragma unroll
    for (int i0 = 0; i0 < 4; ++i0)
#pragma unroll
        for (int i1 = 0; i1 < 4; ++i1)
#pragma unroll
            for (int i2 = 0; i2 < 4; ++i2) hf[i0][i1][i2] = 0.f;
    auto dir_body = [&](auto dirc) __attribute__((always_inline)) { constexpr int dir = decltype(dirc)::value;
        const bf16_t* wt = (const bf16_t*)(a.ws + WS_WLRU) + (size_t)((dir * 12 + n) * 2) * 16384 + (size_t)c * 128 + 8 * fq;
        bf16x8 wrf[4], wif[4];
#pragma unroll
        for (int ks = 0; ks < 4; ++ks) { wrf[ks] = *(const bf16x8*)(wt + 32 * ks); wif[ks] = *(const bf16x8*)(wt + 16384 + 32 * ks); }
        const float ba = a.lru_ba[dir * 1536 + cg_], bi = a.lru_bi[dir * 1536 + cg_];
        const float lam = a.lru_lambda[dir * 1536 + cg_];
        const float logu = -8.0f * log1pf(__expf(-lam));
        float hc = 0.f, TA = 1.f, TB = 0.f;
        if (PASS2) { const f32x2* ag = (const f32x2*)(a.ws + WS_AGG) + ((size_t)(b * NCHUNK) * 2 + dir) * 1536 + cg_;
            f32x2 pa[NCHUNK];
#pragma unroll
            for (int cc = 0; cc < NCHUNK; ++cc) pa[cc] = ag[(size_t)cc * 2 * 1536];
#pragma unroll
            for (int i = 0; i < NCHUNK; ++i) { const int cc = dir ? NCHUNK - 1 - i : i; const bool use = dir ? (cc > chunk) : (cc < chunk); if (use) hc = pa[cc].x * hc + pa[cc].y; } }
        const int tstart = dir ? SEQ - 1 : 0;
        if (dir == 1) __syncthreads();
#pragma unroll 1
        for (int si = 0; si < 4; ++si) { const int s = dir ? 3 - si : si;
            if (PASS2 && dir == 0) {
#pragma unroll
                for (int i1 = 0; i1 < 4; ++i1)
#pragma unroll
                    for (int i2 = 0; i2 < 4; ++i2) { hf[0][i1][i2] = hf[1][i1][i2]; hf[1][i1][i2] = hf[2][i1][i2]; hf[2][i1][i2] = hf[3][i1][i2]; } }
            f32x4 ar[4], ai[4], ax[4];
#pragma unroll
            for (int rt = 0; rt < 4; ++rt) { ar[rt] = (f32x4){0.f, 0.f, 0.f, 0.f}; ai[rt] = (f32x4){0.f, 0.f, 0.f, 0.f}; ax[rt] = (f32x4){0.f, 0.f, 0.f, 0.f};
#pragma unroll
                for (int ks = 0; ks < 4; ++ks) { const bf16x8 xf = *(const LAS bf16x8*)(AT + (64 * s + 16 * rt + fr) * AT_PITCH + 64 * ks + 16 * fq);
                    ar[rt] = __builtin_amdgcn_mfma_f32_16x16x32_bf16(xf, wrf[ks], ar[rt], 0, 0, 0); ai[rt] = __builtin_amdgcn_mfma_f32_16x16x32_bf16(xf, wif[ks], ai[rt], 0, 0, 0);
                    if (ks == ks0) ax[rt] = __builtin_amdgcn_mfma_f32_16x16x32_bf16(xf, sel, ax[rt], 0, 0, 0); } }
            const int tl0 = 64 * s + 16 * fq;
            float A16 = 1.f, B16 = 0.f;
#pragma unroll
            for (int e = 0; e < 16; ++e) { const int ee = dir ? 15 - e : e; const int rt = ee >> 2, j = ee & 3;
                const float rg = fsig(ar[rt][j] + ba), ig = fsig(ai[rt][j] + bi); const float la = logu * rg; const float av = __expf(la);
                const float mult = (t0 + tl0 + ee == tstart) ? 1.0f : __builtin_amdgcn_sqrtf(fmaxf(1.0f - av * av, 0.f)); const float bv = mult * ig * ax[rt][j];
                ar[rt][j] = av; ai[rt][j] = bv; B16 = av * B16 + bv; A16 = av * A16; }
            const int pos = dir ? 3 - fq : fq;
            float PA = 1.f, PB = 0.f, QA = 1.f, QB = 0.f;
#pragma unroll
            for (int i = 0; i < 4; ++i) { const int k = dir ? 3 - i : i; const float Ak = __shfl(A16, fr + 16 * k), Bk = __shfl(B16, fr + 16 * k);
                if (i < pos) { PB = Ak * PB + Bk; PA = Ak * PA; }
                QB = Ak * QB + Bk; QA = Ak * QA; }
            if (PASS2) {
                float h = PA * hc + PB;
#pragma unroll
                for (int e = 0; e < 16; ++e) { const int ee = dir ? 15 - e : e; const int rt = ee >> 2, j = ee & 3; h = ar[rt][j] * h + ai[rt][j];
                    if (dir == 0) hf[3][rt][j] = h;
                    else { LAS unsigned short* yp = (LAS unsigned short*)(R0 + (tl0 + ee) * AT_PITCH + 2 * c); const float yb = bf2f(*yp);
                        const float u2 = 1.5957691216057308f * (yb + 0.044715f * yb * yb * yb);
                        const float y = (hf[3][rt][j] + h) * yb * fsig(u2);
                        *yp = (unsigned short)(cvt_pk_bf16(y, 0.f) & 0xffffu); } }
                hc = QA * hc + QB;
            } else { TB = QA * TB + QB; TA = QA * TA; }
            if (PASS2 && dir == 1) {
#pragma unroll
                for (int i1 = 0; i1 < 4; ++i1)
#pragma unroll
                    for (int i2 = 0; i2 < 4; ++i2) { hf[3][i1][i2] = hf[2][i1][i2]; hf[2][i1][i2] = hf[1][i1][i2]; hf[1][i1][i2] = hf[0][i1][i2]; } }
        }
        if (!PASS2 && fq == 0) ((f32x2*)(a.ws + WS_AGG))[((size_t)(b * NCHUNK + chunk) * 2 + dir) * 1536 + cg_] = (f32x2){TA, TB};
        };
    dir_body(std::integral_constant<int, 0>{});
    dir_body(std::integral_constant<int, 1>{});
    if (PASS2) {
        __syncthreads();
#pragma unroll
        for (int it = 0; it < 8; ++it) { const int tl = r0 + 32 * it;
            *(u32x4*)((bf16_t*)a.out + (rowbase + t0 + tl) * YP + 512 + n * 128 + 8 * cch) = *(const LAS u32x4*)(R0 + tl * AT_PITCH + 16 * cch); }
    }
}

#define XB_TMO      128
#define XB_XCNT(j)  (256  + 64 * (j))
#define XB_XSUB(j)  (1280 + 64 * (j))
#define XB_XGEN(j)  (2304 + 64 * (j))
#define XB_TOP      3328
#define XB_TOPGEN   3392
#define XCD_BAR_WORDS 3456
#define XB_SPIN_CAP (1u << 18)

__device__ __forceinline__ unsigned xb_ld(unsigned* p)              { return __hip_atomic_load(p, __ATOMIC_RELAXED, __HIP_MEMORY_SCOPE_AGENT); }
__device__ __forceinline__ unsigned xb_add(unsigned* p, unsigned v) { return __hip_atomic_fetch_add(p, v, __ATOMIC_RELAXED, __HIP_MEMORY_SCOPE_AGENT); }
__device__ __forceinline__ unsigned xb_xcc_id() { return (unsigned)__builtin_amdgcn_s_getreg((3 << 11) | 20) & 0xFu; }
#define XB_SPIN(cond, bar) do { unsigned _sp = 0; while (cond) { __builtin_amdgcn_s_sleep(1); \
    if ((++_sp & 255u) == 0u) { if (xb_ld(&(bar)[XB_TMO])) break; if (_sp > XB_SPIN_CAP) { atomicAdd(&(bar)[XB_TMO], 1u); break; } } } } while (0)

struct XcdBarrier {
    unsigned* bar; unsigned x;
    volatile LAS unsigned* st;
};

__device__ __forceinline__ XcdBarrier xcd_barrier_post(unsigned* bar, volatile LAS unsigned* st) {
    XcdBarrier b; b.bar = bar; b.x = xb_xcc_id(); b.st = st;
    if (threadIdx.x == 0) (void)xb_add(&bar[XB_XCNT(b.x)], 1u);
    return b;
}
__device__ __forceinline__ void xcd_barrier_complete(unsigned* bar, unsigned x, unsigned& nloc, unsigned& nx) {
    const unsigned G = gridDim.x * gridDim.y * gridDim.z;
    unsigned sum, cnt, mine, sp = 0u;
    for (;;) {
        sum = 0u; cnt = 0u; mine = 0u;
#pragma unroll
        for (unsigned j = 0; j < 16; ++j) { const unsigned c = xb_ld(&bar[XB_XCNT(j)]); sum += c; cnt += (c > 0u) ? 1u : 0u; mine = (j == x) ? c : mine; }
        if (sum == G) break;
        __builtin_amdgcn_s_sleep(1);
        if ((++sp & 255u) == 0u) { if (xb_ld(&bar[XB_TMO])) break; if (sp > XB_SPIN_CAP) { atomicAdd(&bar[XB_TMO], 1u); break; } }
    }
    nloc = mine > 0u ? mine : 1u; nx = cnt > 0u ? cnt : 1u;
}

__device__ __forceinline__ void xcd_barrier(const XcdBarrier& b) {
    asm volatile("s_waitcnt vmcnt(0)" ::: "memory");
    __syncthreads();
    if (threadIdx.x == 0) {
        unsigned* bar = b.bar;
        __builtin_amdgcn_s_waitcnt(0);
        unsigned nloc = b.st[0], nx = b.st[1];
        if (nloc == 0u) { xcd_barrier_complete(bar, b.x, nloc, nx); b.st[0] = nloc; b.st[1] = nx; }
        const unsigned old = xb_add(&bar[XB_XSUB(b.x)], 1u);
        const unsigned gen = old / nloc;
        if (old + 1u == (gen + 1u) * nloc) {
            __builtin_amdgcn_fence(__ATOMIC_RELEASE, "agent");
            asm volatile("s_waitcnt vmcnt(0)" ::: "memory");
            const unsigned og = xb_add(&bar[XB_TOP], 1u);
            if (og + 1u == (gen + 1u) * nx) xb_add(&bar[XB_TOPGEN], 1u);
        }
        XB_SPIN(xb_ld(&bar[XB_TOPGEN]) == gen, bar);
        __builtin_amdgcn_fence(__ATOMIC_ACQUIRE, "agent");
        asm volatile("s_waitcnt vmcnt(0)" ::: "memory");
    }
    __syncthreads();
}

__global__ void __launch_bounds__(512, 2) mega_fwd(Args a) {
    extern __shared__ __attribute__((aligned(16))) unsigned char lds_raw[];
    Frame F; F.lds = (LAS unsigned char*)lds_raw; F.tid = threadIdx.x; F.lane = F.tid & 63; F.wave = __builtin_amdgcn_readfirstlane(F.tid >> 6); F.G = gridDim.x; F.bid = blockIdx.x;
    cg::grid_group grid = cg::this_grid();
    unsigned char* ws = a.ws;
    const int lo = a.ph_lo, hi = a.ph_hi;
#ifndef REP_MASK
#define REP_MASK 0
#endif
#define NREP(k) ((((REP_MASK) >> (k)) & 1) ? 2 : 1)
#ifndef SUB_MASK
#define SUB_MASK 7
#endif
#ifndef PH_MASK
#define PH_MASK 0x7ff
#endif
#define IN(k) ((((PH_MASK) >> (k)) & 1) && lo <= (k) && (k) < hi)
#define SEAM(k) do { if (IN(k) && IN((k) + 1)) xcd_barrier(xbar); } while (0)
    const int gw = F.bid * 8 + F.wave, NGW = F.G * 8;
    if (F.tid < 2) ((volatile LAS unsigned*)(F.lds + LDS_XB))[F.tid] = 0u;
    __syncthreads();
    if (F.bid == 0) { for (int i = F.tid; i < XCD_BAR_WORDS; i += 512) __hip_atomic_store((unsigned*)(ws + WS_BAR) + i, 0u, __ATOMIC_RELAXED, __HIP_MEMORY_SCOPE_AGENT); }
    XcdBarrier xbar; xbar.bar = (unsigned*)(ws + WS_BAR); xbar.x = 0; xbar.st = (volatile LAS unsigned*)(F.lds + LDS_XB);

    if (IN(0)) for (int rep = 0; rep < NREP(0); ++rep) { phase0(F, a); if (rep + 1 < NREP(0)) __syncthreads(); }
    if (IN(0) && IN(1)) { grid.sync(); xbar = xcd_barrier_post((unsigned*)(ws + WS_BAR), (volatile LAS unsigned*)(F.lds + LDS_XB)); }
    if (IN(1)) {
        { pg8::Gemm g{(const bf16_t*)(ws + WS_H), (const bf16_t*)(ws + WS_WIN), M, NIN, D, D, D}; pg8::StaticOrder S; S.init(M, NIN, F.G, F.bid, NREP(1));
          pg8::EpiBf16<0> E{(bf16_t*)(ws + WS_PROJ), NIN, nullptr}; pg8::gemm_phase(F.lds, g, S, E); }
        { pg8::Gemm g{(const bf16_t*)(ws + WS_MEMN), (const bf16_t*)(ws + WS_WMKV), BATCH * NMEM, 2048, D, D, D}; pg8::StaticOrder S; S.init(BATCH * NMEM, 2048, 32, F.bid >= F.G - 32 ? F.bid - (F.G - 32) : -1);
          pg8::EpiBf16<0> E{(bf16_t*)(ws + WS_KV), 2048, nullptr}; pg8::gemm_phase(F.lds, g, S, E); }
    }
    SEAM(1);
    if (IN(2)) {
        constexpr int N_L = BATCH * NCHUNK * 12, N_A = BATCH * 12 * 32, N_C = BATCH * 4 * 32;
        if (F.bid & 1) {
            for (int it = F.bid; it < N_L; it += F.G) lru_item<false>(F, a, it);
            for (int it = F.bid; it < N_A; it += F.G) attnA_item(F, a, it);
            for (int it = F.bid; it < N_C; it += F.G) attnC_item(F, a, it);
        } else {
            for (int it = F.bid; it < N_A; it += F.G) attnA_item(F, a, it);
            for (int it = F.bid; it < N_C; it += F.G) attnC_item(F, a, it);
            for (int it = F.bid; it < N_L; it += F.G) lru_item<false>(F, a, it);
        }
    }
    SEAM(2);
    if (IN(3)) {
        constexpr int N_L2 = BATCH * NCHUNK * 12;
        const bool gemm_first = ((F.bid >> 3) & 1) == 0;
#define P3_GEMM() do { __syncthreads(); pg8::Gemm g{(const bf16_t*)(ws + WS_H), (const bf16_t*)(ws + WS_WGATE), M, NG, D, D, D}; pg8::StaticOrder S; S.init(M, NG, F.G, F.bid); \
            pg8::EpiGate8 E{ws + WS_PROJ, a.b_gate}; pg8::gemm_phase(F.lds, g, S, E); } while (0)
#define P3_LRU() do { for (int it = F.bid; it < N_L2; it += F.G) lru_item<true>(F, a, it); for (int m = gw; m < M; m += NGW) combine_row(a, (size_t)m, F.lane); } while (0)
        if (gemm_first) { P3_GEMM(); P3_LRU(); } else { P3_LRU(); P3_GEMM(); }
#undef P3_GEMM
#undef P3_LRU
    }
    SEAM(3);
    if (IN(5)) {
        pg8::Gemm g{(const bf16_t*)a.out, (const bf16_t*)(ws + WS_WO), M, D, YP, YP, YP}; pg8::StaticOrder S; S.init(M, D, F.G, F.bid, NREP(5));
        pg8::EpiMix E{(bf16_t*)(ws + WS_H), ws + WS_PROJ}; pg8::gemm_phase(F.lds, g, S, E);
    }
    SEAM(5);
    if (IN(6)) {
        pg8::Gemm g{(const bf16_t*)(ws + WS_H), (const bf16_t*)(ws + WS_WOUT), M, D, D, D, D}; pg8::StaticOrder S; S.init(M, D, F.G, F.bid, NREP(6));
        pg8::EpiBf16<0> E{(bf16_t*)(ws + WS_H2), D, nullptr}; pg8::gemm_phase(F.lds, g, S, E);
    }
    SEAM(6);
    if (IN(7)) { for (int m = gw; m < M; m += NGW) rms_row_add_bf16(a.x + (size_t)m * D, (const bf16_t*)(ws + WS_H2) + (size_t)m * D, a.norm_mlp, (bf16_t*)(ws + WS_H) + (size_t)m * D, F.lane); }
    SEAM(7);
    if (IN(8)) {
        pg8::Gemm g{(const bf16_t*)(ws + WS_H), (const bf16_t*)(ws + WS_WUP), M, DFF, D, D, D}; pg8::StaticOrder S; S.init(M, DFF, F.G, F.bid, NREP(8));
        pg8::EpiBf16<2> E{(bf16_t*)(ws + WS_PROJ), DFF, nullptr}; pg8::gemm_phase(F.lds, g, S, E);
    }
    SEAM(8);
    if (IN(9)) {
        pg8::Gemm g{(const bf16_t*)(ws + WS_PROJ), (const bf16_t*)(ws + WS_WDN), M, D, DFF, DFF, DFF}; pg8::StaticOrder S; S.init(M, D, F.G, F.bid, NREP(9), 4);
        pg8::EpiBf16<0> E{(bf16_t*)(ws + WS_H), D, nullptr}; pg8::gemm_phase(F.lds, g, S, E);
    }
    SEAM(9);
    if (IN(10)) { for (int m = gw; m < M; m += NGW) rms_row_final(a.x + (size_t)m * D, (const bf16_t*)(ws + WS_H2) + (size_t)m * D, (const bf16_t*)(ws + WS_H) + (size_t)m * D, a.norm_final, a.out + (size_t)m * D, F.lane); }
#undef IN
#undef SEAM
}

#ifndef MK_SPLIT
#define MK_SPLIT 0
#endif
extern "C" void kernel_launch(void* const* d_in, const int* in_sizes, int n_in, void* d_out, int out_size, void* d_ws, size_t ws_size, hipStream_t stream) {
    static int grid = 0;
    if (grid == 0) {
        if (n_in != 24 || in_sizes[0] != M * D || out_size != M * D || ws_size < WS_END) { fprintf(stderr, "kernel_launch: unexpected shapes (n_in %d, in0 %d, out %d, ws %zu); nothing launched\n", n_in, n_in > 0 ? in_sizes[0] : -1, out_size, ws_size); grid = -1; return; }
        int dev = 0, cus = 0, per_cu = 0;
        (void)hipGetDevice(&dev); (void)hipDeviceGetAttribute(&cus, hipDeviceAttributeMultiprocessorCount, dev);
        if (hipFuncSetAttribute((const void*)mega_fwd, hipFuncAttributeMaxDynamicSharedMemorySize, LDS_BYTES) != hipSuccess) { fprintf(stderr, "kernel_launch: hipFuncSetAttribute failed\n"); grid = -1; return; }
        if (hipOccupancyMaxActiveBlocksPerMultiprocessor(&per_cu, (const void*)mega_fwd, 512, LDS_BYTES) != hipSuccess || per_cu < 1) { fprintf(stderr, "kernel_launch: occupancy query says %d blocks per CU\n", per_cu); (void)hipGetLastError(); }
        grid = cus > 0 ? cus : 256;
    }
    if (grid < 0) return;
    Args a{};
    const float** p = (const float**)&a;
    for (int i = 0; i < 24; ++i) p[i] = (const float*)d_in[i];
    a.out = (float*)d_out; a.ws = (unsigned char*)d_ws;
#if MK_SPLIT
    for (int ph = 0; ph < 11; ++ph) { a.ph_lo = ph; a.ph_hi = ph + 1; hipLaunchKernelGGL(mega_fwd, dim3(grid), dim3(512), LDS_BYTES, stream, a); }
#else
    a.ph_lo = 0; a.ph_hi = 11;
    void* args[] = {&a};
    hipError_t e = hipLaunchCooperativeKernel((const void*)mega_fwd, dim3(grid), dim3(512), args, LDS_BYTES, stream);
    if (e != hipSuccess) fprintf(stderr, "kernel_launch: cooperative launch failed: %s (grid %d)\n", hipGetErrorString(e), grid);
#endif
}
```
